# Optimizing an MI355X kernel written in HIP

```python
import math
import jax, jax.numpy as jnp
from jax import lax
import numpy as np

D_MODEL = 4096
BATCH = 4
SEQ = 4096
DEPTH = 1

MIX_WIDTH = D_MODEL
ATTN_WIDTH = MIX_WIDTH // 2
POOL_WIDTH = MIX_WIDTH - ATTN_WIDTH
DIFF_HEAD_DIM = 128
N_DIFF_HEADS = ATTN_WIDTH // (2 * DIFF_HEAD_DIM)
V_HEAD_DIM = 2 * DIFF_HEAD_DIM
ROPE_DIM = DIFF_HEAD_DIM // 4
ROPE_THETA = 500000.0
Q_BLOCK = 128
SUBLN_EPS = 1e-5
POOL_WINDOWS = (2, 4, 8, 16)
N_POOL_GROUPS = len(POOL_WINDOWS)
POOL_GROUP_DIM = POOL_WIDTH // N_POOL_GROUPS
MAX_WINDOW = max(POOL_WINDOWS)
IN_WIDTH = 3 * ATTN_WIDTH + POOL_WIDTH
D_FF = ((8 * D_MODEL // 3 + 255) // 256) * 256
CONV_WIDTH = 3
NORM_EPS = 1e-5
POS_OFFSET_MAX = 1024

kernel_name = 'hymba_diffattn_pool_convffn_block'


def rms_norm(x, g, eps):
    x32 = x.astype(jnp.float32)
    y = x32 * lax.rsqrt(jnp.mean(x32 * x32, axis=-1, keepdims=True) + eps)
    return (y * g.astype(jnp.float32)).astype(x.dtype)


def apply_partial_rope(t, cos, sin):
    half = ROPE_DIM // 2
    t32 = t[..., :ROPE_DIM].astype(jnp.float32)
    t1, t2 = t32[..., :half], t32[..., half:]
    rot = jnp.concatenate([t1 * cos - t2 * sin, t2 * cos + t1 * sin], axis=-1).astype(t.dtype)
    return jnp.concatenate([rot, t[..., ROPE_DIM:]], axis=-1)


def diff_attention(q, k, v, lam, subln_g, lambda_init):
    B, S = q.shape[0], q.shape[1]
    q = q * (DIFF_HEAD_DIM ** -0.5)
    outs = []
    for blk in range(S // Q_BLOCK):
        q0 = blk * Q_BLOCK
        kv_len = q0 + Q_BLOCK
        qb = q[:, q0:kv_len]
        kb = k[:, :kv_len]
        vb = v[:, :kv_len]
        s = jnp.einsum('bqhcd,bkhcd->bhcqk', qb, kb).astype(jnp.float32)
        q_idx = q0 + jnp.arange(Q_BLOCK)
        k_idx = jnp.arange(kv_len)
        mask = k_idx[None, :] <= q_idx[:, None]
        s = jnp.where(mask, s, -1e30)
        p = jax.nn.softmax(s, axis=-1)
        a = (p[:, :, 0] - lam * p[:, :, 1]).astype(v.dtype)
        outs.append(jnp.einsum('bhqk,bkhe->bqhe', a, vb))
    o = jnp.concatenate(outs, axis=1)
    o = rms_norm(o, subln_g, SUBLN_EPS) * (1.0 - lambda_init)
    return o.reshape(B, S, ATTN_WIDTH)


def multiscale_pool(u, w_pool, pool_scale):
    B, S, _ = u.shape
    u32 = u.astype(jnp.float32).reshape(B, S, N_POOL_GROUPS, POOL_GROUP_DIM)
    c = jnp.cumsum(u32, axis=1)
    c_pad = jnp.pad(c, ((0, 0), (MAX_WINDOW, 0), (0, 0), (0, 0)))
    counts_base = jnp.arange(1, S + 1)
    groups = []
    for g, w in enumerate(POOL_WINDOWS):
        lagged = c_pad[:, MAX_WINDOW - w:MAX_WINDOW - w + S, g]
        count = jnp.minimum(counts_base, w).astype(jnp.float32)
        mean = (c[:, :, g] - lagged) / count[None, :, None]
        groups.append(mean - u32[:, :, g])
    pooled = jnp.stack(groups, axis=2).astype(u.dtype)
    y = jnp.einsum('bsgc,gcd->bsgd', pooled, w_pool).reshape(B, S, POOL_WIDTH)
    return y * pool_scale


def setup_inputs(seed: int = 0) -> dict:
    key = jax.random.key(seed)
    ks = jax.random.split(key, 20)
    f32 = jnp.float32
    x = jax.random.normal(ks[0], (BATCH, SEQ, D_MODEL), f32)
    offsets = jax.random.randint(ks[1], (BATCH, 1), 0, POS_OFFSET_MAX, dtype=jnp.int32)
    positions = (offsets + jnp.arange(SEQ, dtype=jnp.int32)[None, :]).astype(jnp.int32)
    norm1_g = 1.0 + 0.02 * jax.random.normal(ks[2], (DEPTH, D_MODEL), f32)
    w_in = jax.random.normal(ks[3], (DEPTH, D_MODEL, IN_WIDTH), f32) * D_MODEL ** -0.5
    lambda_q1 = 0.1 * jax.random.normal(ks[4], (DEPTH, DIFF_HEAD_DIM), f32)
    lambda_k1 = 0.1 * jax.random.normal(ks[5], (DEPTH, DIFF_HEAD_DIM), f32)
    lambda_q2 = 0.1 * jax.random.normal(ks[6], (DEPTH, DIFF_HEAD_DIM), f32)
    lambda_k2 = 0.1 * jax.random.normal(ks[7], (DEPTH, DIFF_HEAD_DIM), f32)
    subln_g = 1.0 + 0.02 * jax.random.normal(ks[8], (DEPTH, V_HEAD_DIM), f32)
    w_pool = jax.random.normal(ks[9], (DEPTH, N_POOL_GROUPS, POOL_GROUP_DIM, POOL_GROUP_DIM), f32) * POOL_GROUP_DIM ** -0.5
    pool_scale = 1.0 + 0.02 * jax.random.normal(ks[10], (DEPTH, POOL_WIDTH), f32)
    w_out = jax.random.normal(ks[11], (DEPTH, MIX_WIDTH, D_MODEL), f32) * MIX_WIDTH ** -0.5
    norm2_g = 1.0 + 0.02 * jax.random.normal(ks[12], (DEPTH, D_MODEL), f32)
    w_gate = jax.random.normal(ks[13], (DEPTH, D_MODEL, D_FF), f32) * D_MODEL ** -0.5
    w_up = jax.random.normal(ks[14], (DEPTH, D_MODEL, D_FF), f32) * D_MODEL ** -0.5
    conv_w = jax.random.normal(ks[15], (DEPTH, CONV_WIDTH, D_FF), f32) * CONV_WIDTH ** -0.5
    conv_b = 0.01 * jax.random.normal(ks[16], (DEPTH, D_FF), f32)
    w_down = jax.random.normal(ks[17], (DEPTH, D_FF, D_MODEL), f32) * D_FF ** -0.5
    norm_f_g = 1.0 + 0.02 * jax.random.normal(ks[18], (D_MODEL,), f32)
    return {'x': x, 'positions': positions, 'norm1_g': norm1_g, 'w_in': w_in,
            'lambda_q1': lambda_q1, 'lambda_k1': lambda_k1, 'lambda_q2': lambda_q2, 'lambda_k2': lambda_k2,
            'subln_g': subln_g, 'w_pool': w_pool, 'pool_scale': pool_scale, 'w_out': w_out,
            'norm2_g': norm2_g, 'w_gate': w_gate, 'w_up': w_up, 'conv_w': conv_w, 'conv_b': conv_b,
            'w_down': w_down, 'norm_f_g': norm_f_g}


def reference(x, positions, norm1_g, w_in, lambda_q1, lambda_k1, lambda_q2, lambda_k2, subln_g,
              w_pool, pool_scale, w_out, norm2_g, w_gate, w_up, conv_w, conv_b, w_down, norm_f_g):
    B, S, _ = x.shape
    inv_freq = 1.0 / (ROPE_THETA ** (jnp.arange(0, ROPE_DIM, 2, dtype=jnp.float32) / ROPE_DIM))
    angles = positions.astype(jnp.float32)[..., None] * inv_freq
    cos = jnp.cos(angles)[:, :, None, None, :]
    sin = jnp.sin(angles)[:, :, None, None, :]
    h = x
    for l in range(DEPTH):
        lambda_init = 0.8 - 0.6 * math.exp(-0.3 * l)
        n = rms_norm(h, norm1_g[l], NORM_EPS)
        proj = n @ w_in[l]
        q, k, v, u = jnp.split(proj, [ATTN_WIDTH, 2 * ATTN_WIDTH, 3 * ATTN_WIDTH], axis=-1)
        q = apply_partial_rope(q.reshape(B, S, N_DIFF_HEADS, 2, DIFF_HEAD_DIM), cos, sin)
        k = apply_partial_rope(k.reshape(B, S, N_DIFF_HEADS, 2, DIFF_HEAD_DIM), cos, sin)
        v = v.reshape(B, S, N_DIFF_HEADS, V_HEAD_DIM)
        lam = (jnp.exp(jnp.sum(lambda_q1[l].astype(jnp.float32) * lambda_k1[l].astype(jnp.float32)))
               - jnp.exp(jnp.sum(lambda_q2[l].astype(jnp.float32) * lambda_k2[l].astype(jnp.float32)))
               + lambda_init)
        attn_out = diff_attention(q, k, v, lam, subln_g[l], lambda_init)
        pool_out = multiscale_pool(u, w_pool[l], pool_scale[l])
        h = h + jnp.concatenate([attn_out, pool_out], axis=-1) @ w_out[l]
        n2 = rms_norm(h, norm2_g[l], NORM_EPS)
        gate = n2 @ w_gate[l]
        up = n2 @ w_up[l]
        gp = jnp.pad(gate, ((0, 0), (CONV_WIDTH - 1, 0), (0, 0)))
        cw = conv_w[l]
        conv = conv_b[l] + cw[0] * gp[:, 0:S]
        for j in range(1, CONV_WIDTH):
            conv = conv + cw[j] * gp[:, j:j + S]
        h = h + (jax.nn.silu(conv) * up) @ w_down[l]
    return rms_norm(h, norm_f_g, NORM_EPS)
```

```cpp
#include <hip/hip_runtime.h>
#include <hip/hip_bf16.h>
#include <hip/hip_cooperative_groups.h>
#include <cstdio>
#include <cstdint>
namespace pg8 { __device__ __forceinline__ int mk_tid() { int t = threadIdx.x; asm volatile("" : "+v"(t)); return t; } }
namespace pg8 {
#define PG8_LAS __attribute__((address_space(3)))
typedef unsigned short bf16_t;
typedef short bf16x8 __attribute__((ext_vector_type(8)));
typedef float f32x4 __attribute__((ext_vector_type(4)));
typedef unsigned u32x4 __attribute__((ext_vector_type(4)));
constexpr int BM = 256, BK = 64, HALF = 128, HTB = HALF * BK * 2  , STAGE_BYTES = 8 * HTB, NXCD = 8, WGM = 8;

__host__ __device__ __forceinline__ int lds_byte(int r, int c) { const int st = (r >> 4) * 2 + (c >> 5), rr = r & 15, cc = c & 31, ob = rr * 64 + cc * 2; return st * 1024 + (ob ^ (((ob >> 9) & 1) << 5)); }
__host__ __device__ __forceinline__ void stage_rc(int b, int& R, int& C) { const int st = b / 1024, sb = b % 1024, swz = sb ^ (((sb >> 9) & 1) << 5); R = (st >> 1) * 16 + swz / 64; C = (st & 1) * 32 + (swz % 64) / 2; }
__host__ __device__ __forceinline__ int perm32(int rho) { const int n = rho >> 4, i = rho & 15; return 8 * (i >> 2) + 4 * n + (i & 3); }

struct Unit { int pm, pn, ka; };
struct Gemm { const bf16_t* A; const bf16_t* Bt; int M, N, K, lda, ldb; };
struct StaticOrder {
    int nM, nN, nwg, G, c;
    __host__ __device__ void init(int M, int N, int G_, int c_) { nM = M / BM; nN = N / BM; nwg = nM * nN; G = G_; c = c_; }
    __host__ __device__ bool next(int i, Unit& u) const {
        const long L = (long)i * G + c; if (L >= nwg) return false;
        int wgid = (int)L; { const int q = nwg / NXCD, r = nwg % NXCD, xcd = wgid % NXCD, off = wgid / NXCD; wgid = (xcd < r ? xcd * (q + 1) : r * (q + 1) + (xcd - r) * q) + off; }
        const int nig = WGM * nN, gid = wgid / nig, fm = gid * WGM, gsz = (nM - fm) < WGM ? (nM - fm) : WGM;
        u.pm = fm + ((wgid % nig) % gsz); u.pn = (wgid % nig) / gsz; u.ka = 0; return true;
    }
    __device__ __forceinline__ void a_ready(const Unit&) const {}
    __device__ __forceinline__ void done(const Unit&) const {}
};
__device__ __forceinline__ unsigned cvt_pk_bf16(float lo, float hi) { unsigned r; asm volatile("v_cvt_pk_bf16_f32 %0, %1, %2" : "=v"(r) : "v"(lo), "v"(hi)); return r; }
template <class Epi, class Sched, bool ALIGN_EPI = false, bool SP2 = false>
__device__ __forceinline__ void gemm_phase(PG8_LAS unsigned char* lds, const Gemm g, const Sched& S, const Epi& E) {
    const int tid = mk_tid(), wid = __builtin_amdgcn_readfirstlane(tid >> 6), lane = tid & 63, wr = wid >> 2, wc = wid & 3, fr = lane & 15, fq = lane >> 4;
    const int K = g.K, nt = K / BK;
    unsigned voffA[2], voffB[2];
#pragma unroll
    for (int i = 0; i < 2; ++i) { int R, C; stage_rc(tid * 16 + i * 8192, R, C); const int Rb = Epi::PERM ? ((R & ~31) + perm32(R & 31)) : R;
        voffA[i] = Epi::HB2 ? (unsigned)((((R >> 6) * 8 + ((R & 63) >> 4)) * (g.lda >> 5) + (C >> 5)) * 1024 + (R & 15) * 64 + (C & 31) * 2) : Epi::ABLK ? (unsigned)(((R >> 4) * (g.lda >> 5) + (C >> 5)) * 1024 + (R & 15) * 64 + (C & 31) * 2) : (unsigned)((Epi::HALO ? ((R >> 6) * 128 + (R & 63)) : R) * g.lda + C) * 2u; voffB[i] = (unsigned)(((R >> 4) * (g.ldb >> 5) + (C >> 5)) * 1024 + (R & 15) * 64 + (C & 31) * 2); static_assert(Epi::PERM, "blocked weights are stored in PERM slot order"); }
    const size_t kstep = (Epi::HB2 || Epi::ABLK) ? (size_t)2048 : (size_t)(BK * 2), kstepB = 2048;
    const size_t hstepA = (size_t)(Epi::HALO ? 64 : HALF) * g.lda * 2, hstepB = (size_t)HALF * g.ldb * 2;
    const size_t tstepA = (size_t)((Epi::HALO && !Epi::HB2) ? 254 : BM) * g.lda * 2, tstepB = 2 * hstepB;
    const unsigned ldsw = (unsigned)wid * 1024u;
    const int aoff = lds_byte(wr * 64 + fr, fq * 8), boff = lds_byte(wc * 32 + fr, fq * 8);
#define PG8_SA(b, h) (((b) * 2 + (h)) * HTB)
#define PG8_SB(b, h) ((4 + (b) * 2 + (h)) * HTB)
#define PG8_STAGE(bufoff, gbase, voff) do { _Pragma("unroll") for (int _i = 0; _i < 2; ++_i) \
        __builtin_amdgcn_global_load_lds((const unsigned*)((const char*)(gbase) + (voff)[_i]), (PG8_LAS unsigned*)(lds + (bufoff) + ldsw + _i * 8192), 16, 0, 0); } while (0)
#define PG8_LDA(dst, b, h) do { _Pragma("unroll") for (int m = 0; m < 4; ++m) _Pragma("unroll") for (int k = 0; k < 2; ++k) dst[m][k] = *(const PG8_LAS bf16x8*)(lds + PG8_SA(b, h) + aoff + m * 2048 + k * 1024); } while (0)
#define PG8_LDB(dst, b, h) do { _Pragma("unroll") for (int n = 0; n < 2; ++n) _Pragma("unroll") for (int k = 0; k < 2; ++k) dst[n][k] = *(const PG8_LAS bf16x8*)(lds + PG8_SB(b, h) + boff + n * 2048 + k * 1024); } while (0)
#define PG8_MMA(ai, bj, At, Bt) do { __builtin_amdgcn_s_setprio(1); _Pragma("unroll") for (int m = 0; m < 4; ++m) _Pragma("unroll") for (int n = 0; n < 2; ++n) _Pragma("unroll") for (int k = 0; k < 2; ++k) \
        acc[ai][bj][m][n] = __builtin_amdgcn_mfma_f32_16x16x32_bf16(Bt[n][k], At[m][k], acc[ai][bj][m][n], 0, 0, 0); __builtin_amdgcn_s_setprio(0); } while (0)
#define PG8_WAIT_V(n) asm volatile("s_waitcnt vmcnt(" #n ")" ::: "memory")
#define PG8_WAIT_L(n) asm volatile("s_waitcnt lgkmcnt(" #n ")" ::: "memory")
#define PG8_BAR __builtin_amdgcn_s_barrier()
#define PG8_SCHED __builtin_amdgcn_sched_barrier(0)
    Unit cur, nxt; int ui = 0;
    if (!S.next(0, cur)) return;
    f32x4 acc[2][2][4][2];
#pragma unroll
    for (int a = 0; a < 2; ++a)
#pragma unroll
        for (int b = 0; b < 2; ++b)
#pragma unroll
            for (int m = 0; m < 4; ++m)
#pragma unroll
                for (int n = 0; n < 2; ++n) acc[a][b][m][n] = (f32x4){0.f, 0.f, 0.f, 0.f};
    bf16x8 At[4][2], B0[2][2], B1[2][2];
    const char* cA = (const char*)g.A + (size_t)cur.pm * tstepA + cur.ka; const char* cB = (const char*)g.Bt + (size_t)cur.pn * tstepB;
    S.a_ready(cur);
    if constexpr (SP2) {
        PG8_STAGE(PG8_SB(0, 0), cB, voffB); PG8_STAGE(PG8_SB(0, 1), cB + hstepB, voffB); PG8_STAGE(PG8_SA(0, 0), cA, voffA); PG8_STAGE(PG8_SA(0, 1), cA + hstepA, voffA);
        if (wr == 1) PG8_BAR;
        PG8_WAIT_V(2); PG8_BAR;
        PG8_STAGE(PG8_SB(1, 0), cB + kstepB, voffB); PG8_STAGE(PG8_SA(1, 0), cA + kstep, voffA); PG8_STAGE(PG8_SB(1, 1), cB + hstepB + kstepB, voffB);
        PG8_WAIT_V(6); PG8_BAR;
    } else {
        PG8_STAGE(PG8_SB(0, 0), cB, voffB); PG8_STAGE(PG8_SA(0, 0), cA, voffA); PG8_STAGE(PG8_SB(0, 1), cB + hstepB, voffB); PG8_STAGE(PG8_SA(0, 1), cA + hstepA, voffA);
        if (wr == 1) PG8_BAR;
        PG8_WAIT_V(4); PG8_BAR;
        PG8_STAGE(PG8_SB(1, 0), cB + kstepB, voffB); PG8_STAGE(PG8_SA(1, 0), cA + kstep, voffA); PG8_STAGE(PG8_SB(1, 1), cB + hstepB + kstepB, voffB);
        PG8_WAIT_V(6); PG8_BAR;
    }
    for (;;) {
        const bool has_next = S.next(ui + 1, nxt);
        const char* nA = has_next ? (const char*)g.A + (size_t)nxt.pm * tstepA + nxt.ka : cA; const char* nB = has_next ? (const char*)g.Bt + (size_t)nxt.pn * tstepB : cB;
        for (int t = 0; t < nt; t += 2) {
            const bool last = (t == nt - 2);
            const char* a1 = cA + (size_t)(t + 1) * kstep;
            const char* a2 = last ? nA : cA + (size_t)(t + 2) * kstep; const char* b2 = last ? nB : cB + (size_t)(t + 2) * kstepB;
            const char* a3 = a2 + kstep; const char* b3 = b2 + kstepB;
            if (last && has_next) S.a_ready(nxt);
            if constexpr (SP2) {
            PG8_LDB(B0, 0, 0); PG8_LDB(B1, 0, 1); PG8_SCHED; PG8_LDA(At, 0, 0); PG8_STAGE(PG8_SA(1, 1), a1 + hstepA, voffA);
            PG8_WAIT_V(8); PG8_WAIT_L(0); PG8_BAR; PG8_MMA(0, 0, At, B0); PG8_MMA(0, 1, At, B1); PG8_BAR; PG8_SCHED;
            PG8_LDA(At, 0, 1); PG8_STAGE(PG8_SB(0, 0), b2, voffB); PG8_STAGE(PG8_SB(0, 1), b2 + hstepB, voffB); PG8_STAGE(PG8_SA(0, 0), a2, voffA);
            PG8_WAIT_V(8); PG8_WAIT_L(0); PG8_BAR; PG8_MMA(1, 0, At, B0); PG8_MMA(1, 1, At, B1); PG8_BAR; PG8_SCHED;
            PG8_LDB(B0, 1, 0); PG8_LDB(B1, 1, 1); PG8_SCHED; PG8_LDA(At, 1, 0); PG8_STAGE(PG8_SA(0, 1), a2 + hstepA, voffA);
            PG8_WAIT_V(8); PG8_WAIT_L(0); PG8_BAR; PG8_MMA(0, 0, At, B0); PG8_MMA(0, 1, At, B1); PG8_BAR; PG8_SCHED;
            PG8_LDA(At, 1, 1); PG8_STAGE(PG8_SB(1, 0), b3, voffB); PG8_STAGE(PG8_SB(1, 1), b3 + hstepB, voffB); PG8_STAGE(PG8_SA(1, 0), a3, voffA);
            PG8_WAIT_V(8); PG8_WAIT_L(0); PG8_BAR; PG8_MMA(1, 0, At, B0); PG8_MMA(1, 1, At, B1); PG8_BAR; PG8_SCHED;
            } else {
            PG8_LDB(B0, 0, 0); PG8_SCHED; PG8_LDA(At, 0, 0); PG8_STAGE(PG8_SA(1, 1), a1 + hstepA, voffA);
            PG8_WAIT_L(8); PG8_BAR; PG8_WAIT_L(0); PG8_MMA(0, 0, At, B0); PG8_BAR; PG8_SCHED;
            PG8_LDB(B1, 0, 1); PG8_STAGE(PG8_SB(0, 0), b2, voffB);
            PG8_BAR; PG8_WAIT_L(0); PG8_MMA(0, 1, At, B1); PG8_BAR;
            PG8_LDA(At, 0, 1); PG8_STAGE(PG8_SA(0, 0), a2, voffA);
            PG8_BAR; PG8_WAIT_L(0); PG8_MMA(1, 0, At, B0); PG8_BAR; PG8_SCHED;
            PG8_STAGE(PG8_SB(0, 1), b2 + hstepB, voffB);
            PG8_WAIT_V(6); PG8_BAR; PG8_MMA(1, 1, At, B1); PG8_BAR;
            PG8_LDB(B0, 1, 0); PG8_SCHED; PG8_LDA(At, 1, 0); PG8_STAGE(PG8_SA(0, 1), a2 + hstepA, voffA);
            PG8_WAIT_L(8); PG8_BAR; PG8_WAIT_L(0); PG8_MMA(0, 0, At, B0); PG8_BAR; PG8_SCHED;
            PG8_LDB(B1, 1, 1); PG8_STAGE(PG8_SB(1, 0), b3, voffB);
            PG8_BAR; PG8_WAIT_L(0); PG8_MMA(0, 1, At, B1); PG8_BAR;
            PG8_LDA(At, 1, 1); PG8_STAGE(PG8_SA(1, 0), a3, voffA);
            PG8_BAR; PG8_WAIT_L(0); PG8_MMA(1, 0, At, B0); PG8_BAR; PG8_SCHED;
            PG8_STAGE(PG8_SB(1, 1), b3 + hstepB, voffB);
            PG8_WAIT_V(6); PG8_BAR; PG8_MMA(1, 1, At, B1); PG8_BAR;
            }
        }
        if constexpr (ALIGN_EPI) { if (wr == 0) PG8_BAR; }
        if constexpr (!Epi::AFTER_DRAIN) { E(acc, cur, wr, wc, fr, fq); S.done(cur); }
        if (!has_next) break;
#pragma unroll
        for (int a = 0; a < 2; ++a)
#pragma unroll
            for (int b = 0; b < 2; ++b)
#pragma unroll
                for (int m = 0; m < 4; ++m)
#pragma unroll
                    for (int n = 0; n < 2; ++n) acc[a][b][m][n] = (f32x4){0.f, 0.f, 0.f, 0.f};
        cur = nxt; cA = nA; cB = nB; ++ui;
        if constexpr (ALIGN_EPI) { if (wr == 1) PG8_BAR; }
    }
    PG8_WAIT_V(0);
    if constexpr (!ALIGN_EPI) { if (wr == 0) PG8_BAR; }
    PG8_BAR;
    if constexpr (Epi::AFTER_DRAIN) { E.fused(acc, cur, wr, wc, fr, fq, lds, wid, lane); S.done(cur); }
#undef PG8_SA
#undef PG8_SB
#undef PG8_STAGE
#undef PG8_LDA
#undef PG8_LDB
#undef PG8_MMA
#undef PG8_WAIT_V
#undef PG8_WAIT_L
#undef PG8_BAR
#undef PG8_SCHED
}
}
namespace attn {
constexpr int D = 128, PITCH = 2048;
constexpr float THR = 8.f;
constexpr bool WSKIP = false;
constexpr float SCALE = 0.08838834764831845f;
constexpr int NW = 8, QBLK = 32, KVBLK = 64, QB = NW * QBLK;
constexpr int SHM_V = KVBLK * D * 2, SHM_K = KVBLK * D * 2;
constexpr int LDS_BYTES = 2 * SHM_V + 2 * SHM_K + NW * 64 * 4;
using bf16 = __hip_bfloat16;
typedef short bf16x8 __attribute__((ext_vector_type(8)));
typedef short s16x4 __attribute__((ext_vector_type(4)));
typedef float f32x16 __attribute__((ext_vector_type(16)));
typedef float f32x4 __attribute__((ext_vector_type(4)));
typedef unsigned u32x4 __attribute__((ext_vector_type(4)));
template <class A, class Bt> struct same_t { static constexpr bool v = false; };
template <class A> struct same_t<A, A> { static constexpr bool v = true; };

#define KSWZ(row, colB) ((row) * 256 + ((colB) ^ (((row) & 7) << 4)))
#define SBAR() __builtin_amdgcn_sched_barrier(0)
__device__ __forceinline__ int v_st(int k, int c) { const int kk = (k & ~0xC) | ((k & 4) << 1) | ((k & 8) >> 1); return ((kk >> 3) * 4 + (c >> 5)) * 512 + ((kk & 7) * 32 + (c & 31)) * 2; }
__device__ __forceinline__ int v_rd_base(int lane) { return ((lane & 3) << 3) | (((lane >> 2) & 3) << 6) | (((lane >> 4) & 1) << 5) | (((lane >> 5) & 1) << 8); }
constexpr int v_rd_off(int d0, int ks, int half) { return d0 * 512 + ks * 4096 + half * 2048; }
__device__ __forceinline__ int crow(int r, int hi) { return (r & 3) + 8 * (r >> 2) + 4 * hi; }
__device__ __forceinline__ unsigned cvtpk(float lo, float hi) {
    unsigned r; asm volatile("v_cvt_pk_bf16_f32 %0, %1, %2" : "=v"(r) : "v"(lo), "v"(hi)); return r;
}
__device__ __forceinline__ bf16x8 pack8(f32x4 a, f32x4 b) {
    u32x4 w = {cvtpk(a[0], a[1]), cvtpk(a[2], a[3]), cvtpk(b[0], b[1]), cvtpk(b[2], b[3])};
    return *reinterpret_cast<bf16x8*>(&w);
}
template <class T> __device__ __forceinline__ bf16x8 load8(const T* p) {
    if constexpr (same_t<T, float>::v) { return pack8(*(const f32x4*)p, *(const f32x4*)(p + 4)); }
    else { return *reinterpret_cast<const bf16x8*>(p); }
}
__device__ __forceinline__ void mask_tile(f32x16& p0, f32x16& p1, int dq, unsigned W) {
    const float NEG = -__builtin_inff();
#pragma unroll
    for (int r = 0; r < 16; ++r) {
        const int c = (r & 3) + 8 * (r >> 2);
        if ((unsigned)(dq - c) >= W) p0[r] = NEG;
        if ((unsigned)(dq - c - 32) >= W) p1[r] = NEG;
    }
}
__device__ __forceinline__ void partialSM(f32x16& p0, f32x16& p1, float& m_reg, float& mn, float& alpha) {
    float pmax = p0[0]; for (int r = 1; r < 16; ++r) pmax = fmaxf(pmax, p0[r]); for (int r = 0; r < 16; ++r) pmax = fmaxf(pmax, p1[r]);
    { auto rr = __builtin_amdgcn_permlane32_swap(__float_as_uint(pmax), __float_as_uint(pmax), false, false);
      pmax = fmaxf(__uint_as_float(rr[0]), __uint_as_float(rr[1])); }
    constexpr float C2 = 1.4426950408889634f * SCALE;
    if (__builtin_expect(__all((pmax - m_reg) * SCALE <= THR), 1)) { mn = m_reg; alpha = 1.f; }
    else { mn = fmaxf(m_reg, pmax); alpha = __builtin_amdgcn_exp2f((m_reg - mn) * C2); m_reg = mn; }
    const float mnL = -mn * C2;
    for (int r = 0; r < 16; ++r) p0[r] = fmaf(p0[r], C2, mnL); for (int r = 0; r < 16; ++r) p1[r] = fmaf(p1[r], C2, mnL);
    for (int r = 0; r < 16; ++r) p0[r] = __builtin_amdgcn_exp2f(p0[r]);
}
__device__ __forceinline__ void finishSM(f32x16& p0, f32x16& p1, float alpha, float& l_reg, bf16x8& pa0, bf16x8& pa1, bf16x8& pa2, bf16x8& pa3) {
    for (int r = 0; r < 16; ++r) p1[r] = __builtin_amdgcn_exp2f(p1[r]);
    float ps = 0; for (int r = 0; r < 16; ++r) ps += p0[r]; for (int r = 0; r < 16; ++r) ps += p1[r];
    { auto rr = __builtin_amdgcn_permlane32_swap(__float_as_uint(ps), __float_as_uint(ps), false, false);
      ps = __uint_as_float(rr[0]) + __uint_as_float(rr[1]); }
    l_reg = l_reg * alpha + ps;
#define PK4(P, B_, OUT) do { unsigned a0 = cvtpk(P[B_+0], P[B_+1]), a1 = cvtpk(P[B_+2], P[B_+3]);                          \
        unsigned b0 = cvtpk(P[B_+4], P[B_+5]), b1 = cvtpk(P[B_+6], P[B_+7]);                                             \
        auto r0 = __builtin_amdgcn_permlane32_swap(a0, b0, false, false); auto r1 = __builtin_amdgcn_permlane32_swap(a1, b1, false, false); \
        u32x4 w = {r0[0], r1[0], r0[1], r1[1]}; OUT = *reinterpret_cast<bf16x8*>(&w); } while (0)
    PK4(p0, 0, pa0); PK4(p0, 8, pa1); PK4(p1, 0, pa2); PK4(p1, 8, pa3);
#undef PK4
}
template <int KB, bool SK>
__device__ __forceinline__ void qkt(f32x16& p0, f32x16& p1, const char* K_lds, int r32, int hi, const bf16x8* qr, bool act) {
    if (SK && !act) { const float NEG = -__builtin_inff();
#pragma unroll
        for (int r = 0; r < 16; ++r) { p0[r] = NEG; p1[r] = NEG; } return; }
    p0 = f32x16{}; p1 = f32x16{};
    const char* kb[4];
#pragma unroll
    for (int dd = 0; dd < 4; ++dd) kb[dd] = K_lds + KB * SHM_K + KSWZ(r32, (dd * 16 + hi * 8) * 2);
#pragma unroll
    for (int d0 = 0; d0 < 8; ++d0) { const char* a = kb[d0 & 3] + (d0 >> 2) * 128;
        bf16x8 b0 = *reinterpret_cast<const bf16x8*>(a);
        bf16x8 b1 = *reinterpret_cast<const bf16x8*>(a + 32 * 256);
        p0 = __builtin_amdgcn_mfma_f32_32x32x16_bf16(b0, qr[d0], p0, 0, 0, 0);
        p1 = __builtin_amdgcn_mfma_f32_32x32x16_bf16(b1, qr[d0], p1, 0, 0, 0); }
}
template <int VB, bool SK>
__device__ __forceinline__ void pv_tile(f32x16* o, int vb0, bf16x8 pa0, bf16x8 pa1, bf16x8 pa2, bf16x8 pa3, bool act) {
    if (SK && !act) return;
#define TRRD(dst, off) asm volatile("ds_read_b64_tr_b16 %0, %1 offset:%2" : "=&v"(dst) : "v"(vb0), "i"(off) : "memory")
#define PV_D0(d0) do { s16x4 l0, l1, l2, l3, h0, h1, h2, h3; constexpr int b_ = VB * SHM_V + v_rd_off(d0, 0, 0);     \
        TRRD(l0, b_); TRRD(h0, b_ + 2048); TRRD(l1, b_ + 4096); TRRD(h1, b_ + 6144); TRRD(l2, b_ + 8192); TRRD(h2, b_ + 10240); TRRD(l3, b_ + 12288); TRRD(h3, b_ + 14336); \
        asm volatile("s_waitcnt lgkmcnt(0)" ::: "memory"); SBAR();                 \
        o[d0] = __builtin_amdgcn_mfma_f32_32x32x16_bf16(pa0, (bf16x8){l0[0], l0[1], l0[2], l0[3], h0[0], h0[1], h0[2], h0[3]}, o[d0], 0, 0, 0);   \
        o[d0] = __builtin_amdgcn_mfma_f32_32x32x16_bf16(pa1, (bf16x8){l1[0], l1[1], l1[2], l1[3], h1[0], h1[1], h1[2], h1[3]}, o[d0], 0, 0, 0);   \
        o[d0] = __builtin_amdgcn_mfma_f32_32x32x16_bf16(pa2, (bf16x8){l2[0], l2[1], l2[2], l2[3], h2[0], h2[1], h2[2], h2[3]}, o[d0], 0, 0, 0);   \
        o[d0] = __builtin_amdgcn_mfma_f32_32x32x16_bf16(pa3, (bf16x8){l3[0], l3[1], l3[2], l3[3], h3[0], h3[1], h3[2], h3[3]}, o[d0], 0, 0, 0); } while (0)
    PV_D0(0); PV_D0(1); PV_D0(2); PV_D0(3);
#undef PV_D0
#undef TRRD
}

template <class TIn, class TOut> struct BlockRef { const TIn* Q; const TIn* K; const TIn* V; TOut* O; int P0; };
template <class TIn> struct Seam {
    bf16x8 qr[8];
    bf16x8 st_v0, st_v1, st_k0, st_k1; f32x4 sf0, sf1, sf2, sf3;
    f32x4 tq[16];
};
__device__ __forceinline__ int swa_jlo(int P0, int W) { const int lowk = P0 - W + 1; return lowk > 0 ? lowk / KVBLK : 0; }
#define ROW(p, k0, rr) ((p) + (size_t)((k0) + (rr)) * PITCH + sc)
#define VMW() asm volatile("s_waitcnt vmcnt(0)" ::: "memory")
#define VMWN(n) asm volatile("s_waitcnt vmcnt(%0)" :: "i"(n) : "memory")
#define SLOAD_H(Kp, Vp, k0) do { S.st_v0 = load8<TIn>(ROW(Vp, k0, sr)); S.st_v1 = load8<TIn>(ROW(Vp, k0, 32 + sr));              \
                         S.st_k0 = load8<TIn>(ROW(Kp, k0, sr)); S.st_k1 = load8<TIn>(ROW(Kp, k0, 32 + sr)); } while (0)
#define SWRITE_HK(bf) do { *(bf16x8*)(K_lds + (bf) * SHM_K + kws) = S.st_k0; *(bf16x8*)(K_lds + (bf) * SHM_K + kws + 32 * 256) = S.st_k1; } while (0)
#define SWRITE_HV(bf) do { *(bf16x8*)(V_lds + (bf) * SHM_V + vst0) = S.st_v0; *(bf16x8*)(V_lds + (bf) * SHM_V + vst1) = S.st_v1; } while (0)
#define SWRITE_H(bf) do { SWRITE_HV(bf); SWRITE_HK(bf); } while (0)
#define SLOAD_F(p, k0) do { S.sf0 = *(const f32x4*)ROW(p, k0, sr); S.sf1 = *(const f32x4*)(ROW(p, k0, sr) + 4);                \
                            S.sf2 = *(const f32x4*)ROW(p, k0, 32 + sr); S.sf3 = *(const f32x4*)(ROW(p, k0, 32 + sr) + 4); } while (0)
#define SWRITE_KF(bf) do { *(bf16x8*)(K_lds + (bf) * SHM_K + kws) = pack8(S.sf0, S.sf1); *(bf16x8*)(K_lds + (bf) * SHM_K + kws + 32 * 256) = pack8(S.sf2, S.sf3); } while (0)
#define SWRITE_VF(bf) do { *(bf16x8*)(V_lds + (bf) * SHM_V + vst0) = pack8(S.sf0, S.sf1); *(bf16x8*)(V_lds + (bf) * SHM_V + vst1) = pack8(S.sf2, S.sf3); } while (0)
template <class TIn, class TOut>
__device__ __forceinline__ void causal_swa_prime(const BlockRef<TIn, TOut>& cur, int W, char* lds, Seam<TIn>& S) {
    constexpr bool F32 = same_t<TIn, float>::v;
    const int tid = pg8::mk_tid(), wid = __builtin_amdgcn_readfirstlane(tid >> 6), lane = tid & 63, r32 = lane & 31, hi = lane >> 5;
    const int sr = tid >> 4, sc = (tid & 15) * 8, kws = KSWZ(sr, sc * 2); char* K_lds = lds + 2 * SHM_V;
    const int kb0 = swa_jlo(cur.P0, W) * KVBLK;
    for (int d0 = 0; d0 < 8; ++d0) S.qr[d0] = load8<TIn>(cur.Q + (size_t)(wid * QBLK + r32) * PITCH + d0 * 16 + hi * 8);
    if constexpr (F32) { SLOAD_F((const float*)cur.K, kb0); VMW(); SWRITE_KF(0); SBAR(); SLOAD_F((const float*)cur.V, kb0); }
    else { SLOAD_H(cur.K, cur.V, kb0); VMW(); SWRITE_HK(0); }
    __syncthreads();
}
template <class TIn, class TOut>
__device__ __forceinline__ void causal_swa_block(const BlockRef<TIn, TOut>& cur, const BlockRef<TIn, TOut>& nxt, int skv, int W, char* lds, Seam<TIn>& S) {
    constexpr bool F32 = same_t<TIn, float>::v;
    const int tid = pg8::mk_tid(), wid = __builtin_amdgcn_readfirstlane(tid >> 6), lane = tid & 63, r32 = lane & 31, hi = lane >> 5;
    const int j_lo = swa_jlo(cur.P0, W);
    int j_hi = (cur.P0 + QB - 1) / KVBLK + 1; if (j_hi > skv / KVBLK) j_hi = skv / KVBLK;
    const int NT = j_hi - j_lo;
    const int kbn = swa_jlo(nxt.P0, W) * KVBLK;
    const int qlo = cur.P0 + wid * QBLK, qm = qlo + r32 - 4 * hi;
    char* V_lds = lds; char* K_lds = lds + 2 * SHM_V;
    float* ws = (float*)(lds + 2 * SHM_V + 2 * SHM_K) + wid * 64; float* li_l = ws, * al_l = ws + 32;
    float m_reg = -1e30f, l_reg = 0; f32x16 o[4] = {};
    const int sr = tid >> 4, sc = (tid & 15) * 8, vst0 = v_st(sr, sc), vst1 = v_st(32 + sr, sc), kws = KSWZ(sr, sc * 2);
    const int vb0 = (int)(uintptr_t)V_lds + v_rd_base(lane);
    const TIn* Kh = cur.K; const TIn* Vh = cur.V;
#define RESC(a) do { if (__any((a) < 1.f)) { if (hi == 0) al_l[r32] = (a); asm volatile("s_waitcnt lgkmcnt(0)" ::: "memory");              \
                     for (int d_ = 0; d_ < 4; ++d_) for (int r = 0; r < 16; ++r) o[d_][r] *= al_l[crow(r, hi)]; } } while (0)
#define KBASE(t) ((j_lo + (t)) * KVBLK)
#define ACT(t) (KBASE(t) <= qlo + QBLK - 1 && KBASE(t) + KVBLK - 1 >= qlo - W + 1)
#define MASKT(P0_, P1_, t) do { const int kb_ = KBASE(t); if ((!SK || ACT(t)) && (kb_ + KVBLK - 1 > qlo || kb_ <= qlo + QBLK - 1 - W)) mask_tile(P0_, P1_, qm - kb_, (unsigned)W); } while (0)
    constexpr int NQL = F32 ? 16 : 8;
    constexpr bool SK = WSKIP && !F32;
#define SEAM_K0() do { VMWN(NQL); if constexpr (F32) { SWRITE_KF(0); SBAR(); SLOAD_F((const float*)nxt.V, kbn); } else { SWRITE_HK(0); } SBAR(); } while (0)
    f32x16 pA0, pA1, pB0, pB1; float mnA, mnB, alA, alB; bf16x8 pa0, pa1, pa2, pa3;
    if constexpr (F32) { VMW(); SWRITE_VF(0); SBAR(); } else { SWRITE_HV(0); SBAR(); }
    if (NT > 1) { if constexpr (F32) SLOAD_F((const float*)Kh, KBASE(1)); else SLOAD_H(Kh, Vh, KBASE(1)); }
    SBAR(); qkt<0, SK>(pA0, pA1, K_lds, r32, hi, S.qr, ACT(0));
    if constexpr (F32) { if (NT > 1) { VMW(); SWRITE_KF(1); SBAR(); SLOAD_F((const float*)Vh, KBASE(1)); } }
    MASKT(pA0, pA1, 0); partialSM(pA0, pA1, m_reg, mnA, alA);
    if (NT > 1) { VMW(); if constexpr (F32) { SWRITE_VF(1); SBAR(); if (NT > 2) SLOAD_F((const float*)Kh, KBASE(2)); } else SWRITE_H(1); }
    __syncthreads();
#define HALF_STEP(PX0, PX1, mnX, alX, PY0, PY1, alY, t, KB, VB, SB) do {                                                      \
        SBAR(); qkt<KB, SK>(PX0, PX1, K_lds, r32, hi, S.qr, ACT(t));                                             \
        finishSM(PY0, PY1, alY, l_reg, pa0, pa1, pa2, pa3); SBAR();                                                           \
        if ((t) + 1 < NT) { if constexpr (F32) { VMW(); SWRITE_KF(SB); SBAR(); SLOAD_F((const float*)Vh, KBASE((t) + 1)); }  \
                            else { SLOAD_H(Kh, Vh, KBASE((t) + 1)); } SBAR(); }                                               \
        pv_tile<VB, SK>(o, vb0, pa0, pa1, pa2, pa3, ACT((t) - 1)); MASKT(PX0, PX1, (t)); partialSM(PX0, PX1, m_reg, mnX, alX);                                        \
        __syncthreads();                                                                                                      \
        if ((t) + 1 < NT) { VMW(); if constexpr (F32) { SWRITE_VF(SB); SBAR(); if ((t) + 2 < NT) SLOAD_F((const float*)Kh, KBASE((t) + 2)); } \
                            else { SWRITE_H(SB); } }                                                                          \
        RESC(alX); __syncthreads(); } while (0)
    for (int t = 1; t + 1 < NT; t += 2) {
        HALF_STEP(pB0, pB1, mnB, alB, pA0, pA1, alA, t, 1, 0, 0);
        HALF_STEP(pA0, pA1, mnA, alA, pB0, pB1, alB, t + 1, 0, 1, 1);
    }
    const bool even = (NT & 1) == 0;
    if (even) { SBAR(); qkt<1, SK>(pB0, pB1, K_lds, r32, hi, S.qr, ACT(NT - 1)); SBAR(); }
#define QROW(e) (nxt.Q + (size_t)(wid * QBLK + r32) * PITCH + ((e) >> 1) * 16 + hi * 8 + ((e) & 1) * 4)
    if constexpr (F32) { SLOAD_F((const float*)nxt.K, kbn); SBAR();
#pragma unroll
        for (int e = 0; e < 8; ++e) S.tq[e] = *(const f32x4*)QROW(e); }
    else { SLOAD_H(nxt.K, nxt.V, kbn); SBAR();
#pragma unroll
        for (int d0 = 0; d0 < 8; ++d0) S.qr[d0] = load8<TIn>(nxt.Q + (size_t)(wid * QBLK + r32) * PITCH + d0 * 16 + hi * 8); }
    SBAR();
    finishSM(pA0, pA1, alA, l_reg, pa0, pa1, pa2, pa3); SBAR();
    if constexpr (F32) {
#pragma unroll
        for (int e = 8; e < 16; ++e) S.tq[e] = *(const f32x4*)QROW(e); SBAR(); }
#undef QROW
    pv_tile<0, SK>(o, vb0, pa0, pa1, pa2, pa3, ACT(even ? NT - 2 : NT - 1));
    if (even) { MASKT(pB0, pB1, NT - 1); partialSM(pB0, pB1, m_reg, mnB, alB); __syncthreads(); RESC(alB);
        finishSM(pB0, pB1, alB, l_reg, pa0, pa1, pa2, pa3); SBAR(); pv_tile<1, SK>(o, vb0, pa0, pa1, pa2, pa3, ACT(NT - 1)); }
    SBAR(); SEAM_K0();
    if (hi == 0) li_l[r32] = l_reg; asm volatile("s_waitcnt lgkmcnt(0)" ::: "memory");
    float rli[16];
#pragma unroll
    for (int r = 0; r < 16; ++r) rli[r] = __builtin_amdgcn_rcpf(li_l[crow(r, hi)]);
    TOut* Ow = cur.O + (size_t)(wid * QBLK) * PITCH;
#pragma unroll
    for (int r = 0; r < 16; ++r) { const int orow = crow(r, hi);
#pragma unroll
        for (int d0 = 0; d0 < 4; ++d0) { const float v = o[d0][r] * rli[r];
            if constexpr (same_t<TOut, float>::v) { Ow[(size_t)orow * PITCH + d0 * 32 + r32] = v; }
            else { const float vn = __shfl_xor(v, 1);
                   if ((r32 & 1) == 0) *(unsigned*)(Ow + (size_t)orow * PITCH + d0 * 32 + r32) = cvtpk(v, vn); } } }
    if constexpr (F32) {
#pragma unroll
        for (int d0 = 0; d0 < 8; ++d0) S.qr[d0] = pack8(S.tq[2 * d0], S.tq[2 * d0 + 1]); }
    __syncthreads();
#undef RESC
#undef KBASE
#undef ACT
#undef MASKT
#undef SEAM_K0
#undef HALF_STEP
}
#undef ROW
#undef VMW
#undef VMWN
#undef SLOAD_H
#undef SWRITE_HK
#undef SWRITE_HV
#undef SWRITE_H
#undef SLOAD_F
#undef SWRITE_KF
#undef SWRITE_VF

}

namespace cg = cooperative_groups;
#define LAS __attribute__((address_space(3)))
typedef unsigned short bf16;
typedef unsigned v4u __attribute__((ext_vector_type(4)));
typedef unsigned v2u __attribute__((ext_vector_type(2)));
typedef float f32x4 __attribute__((ext_vector_type(4)));

constexpr int NB = 4, SEQ = 4096, DM = 4096, M = NB * SEQ, AW = 2048, PW = 2048, INW = 8192, DFF = 11008, NHEAD = 8;
constexpr float NORM_EPS = 1e-5f, SUBLN_EPS = 1e-5f;
constexpr int NWAVES = 8, NTHREADS = 512;
constexpr int LDS_BYTES = 147456;

constexpr size_t MiB = 1u << 20;
constexpr size_t WS_SS1 = 0, WS_SS2 = 64 * 1024;
constexpr size_t WS_BAR = 128 * 1024, WS_BAR_BYTES = 16 * 1024;
constexpr size_t WS_COS = 1 * MiB, WS_SIN = 2 * MiB;
constexpr size_t WS_WGATE = 4 * MiB;
constexpr size_t WS_WUP = 90 * MiB;
constexpr size_t WS_HB = 176 * MiB;
constexpr size_t WS_GATE = 304 * MiB;
constexpr size_t WS_HID = 648 * MiB;
constexpr size_t WS_WIN = 304 * MiB, WS_WOUT = 368 * MiB, WS_WPOOL = 400 * MiB;
constexpr size_t WS_N1 = 402 * MiB;
constexpr size_t WS_Q = 530 * MiB, WS_K = 594 * MiB, WS_V = 658 * MiB, WS_U = 722 * MiB;
constexpr size_t WS_POOLED = 786 * MiB, WS_O0 = 850 * MiB, WS_O1 = 914 * MiB;
constexpr size_t WS_END = 992 * MiB;
static_assert(WS_WGATE + (size_t)DFF * DM * 2 <= WS_WUP && WS_WUP + (size_t)DFF * DM * 2 <= WS_HB && WS_HB + (size_t)65 * 256 * DM * 2 <= WS_WOUT, "ws map 1");
static_assert(WS_GATE + (size_t)M * DFF * 2 <= WS_HID && WS_HID + (size_t)M * DFF * 2 <= WS_END, "ws map 2");
static_assert(WS_O1 + (size_t)M * 2048 * 2 <= WS_END && WS_WIN + (size_t)INW * DM * 2 <= WS_WOUT && WS_WOUT + (size_t)DM * DM * 2 <= WS_WPOOL && WS_WPOOL + 2 * MiB <= WS_N1, "ws map 3");

__device__ __forceinline__ float bf2f(unsigned short b) { return __uint_as_float((unsigned)b << 16); }
__device__ __forceinline__ float bflo(unsigned w) { return __uint_as_float(w << 16); }
__device__ __forceinline__ float bfhi(unsigned w) { return __uint_as_float(w & 0xffff0000u); }
__device__ __forceinline__ unsigned pk2(float lo, float hi) { return pg8::cvt_pk_bf16(lo, hi); }
__device__ __forceinline__ size_t blk_off(int row, int col, int ld) { return ((size_t)(row >> 4) * (ld >> 5) + (col >> 5)) * 512 + (row & 15) * 32 + (col & 31); }
__device__ __forceinline__ int hb_row(int t) { return t + 2 + 2 * (t / 254); }
__device__ __forceinline__ float wave_sum(float v) {
#pragma unroll
    for (int o = 1; o < 64; o <<= 1) v += __shfl_xor(v, o);
    return v;
}

namespace pg8 {
struct EpiQKVU {
    static constexpr bool PERM = true, AFTER_DRAIN = false, HALO = false, HB2 = false, ABLK = false;
    bf16_t* O; const float* cosT; const float* sinT;
    __device__ __forceinline__ void operator()(const f32x4 (&acc)[2][2][4][2], const Unit& u, int wr, int wc, int fr, int fq) const {
        const int t = u.pn >> 3;
        bf16_t* base = O + (size_t)t * ((size_t)M * 2048);
        const int row0 = u.pm * BM + wr * 64 + fr;
        const bool ev = (fr & 1) == 0;
        const int cst = (u.pn & 7) * BM + wc * 64 + 8 * fq + (ev ? 0 : 32);
        const bool rope = (t < 2) && ((wc & 1) == 0);
        const float sgn = (fq < 2) ? -1.f : 1.f;
#pragma unroll
        for (int ai = 0; ai < 2; ++ai) {
            f32x4 c0[4], c1[4], s0[4], s1[4];
            if (rope) {
#pragma unroll
                for (int m = 0; m < 4; ++m) { const size_t ro = (size_t)(row0 + ai * HALF + m * 16) * 16 + 8 * (fq & 1);
                    c0[m] = *(const f32x4*)(cosT + ro); c1[m] = *(const f32x4*)(cosT + ro + 4); s0[m] = *(const f32x4*)(sinT + ro); s1[m] = *(const f32x4*)(sinT + ro + 4); }
                asm volatile("" ::: "memory");
            }
#pragma unroll
            for (int m = 0; m < 4; ++m) {
                const int rowE = (row0 + ai * HALF + m * 16) & ~1;
                f32x4 v00 = acc[ai][0][m][0], v01 = acc[ai][0][m][1];
                const f32x4 v10 = acc[ai][1][m][0], v11 = acc[ai][1][m][1];
                if (rope) {
                    f32x4 p0, p1;
#pragma unroll
                    for (int j = 0; j < 4; ++j) { p0[j] = __shfl_xor(v00[j], 32); p1[j] = __shfl_xor(v01[j], 32); }
                    v00 = v00 * c0[m] + p0 * (s0[m] * sgn); v01 = v01 * c1[m] + p1 * (s1[m] * sgn);
                }
                u32x4 w0, w1;
                w0.x = cvt_pk_bf16(v00[0], v00[1]); w0.y = cvt_pk_bf16(v00[2], v00[3]); w0.z = cvt_pk_bf16(v01[0], v01[1]); w0.w = cvt_pk_bf16(v01[2], v01[3]);
                w1.x = cvt_pk_bf16(v10[0], v10[1]); w1.y = cvt_pk_bf16(v10[2], v10[3]); w1.z = cvt_pk_bf16(v11[0], v11[1]); w1.w = cvt_pk_bf16(v11[2], v11[3]);
                u32x4 rcv;
#pragma unroll
                for (int j = 0; j < 4; ++j) { const unsigned snd = ev ? w1[j] : w0[j]; rcv[j] = (unsigned)__shfl_xor((int)snd, 1); }
                u32x4 d1, d2;
#pragma unroll
                for (int j = 0; j < 4; ++j) { d1[j] = ev ? w0[j] : rcv[j]; d2[j] = ev ? rcv[j] : w1[j]; }
                *(u32x4*)(base + (size_t)rowE * 2048 + cst) = d1;
                *(u32x4*)(base + (size_t)(rowE + 1) * 2048 + cst) = d2;
            }
            asm volatile("" ::: "memory");
        }
    }
};
__device__ __forceinline__ float rs_of(float ss) { return __builtin_amdgcn_rsqf(ss * (1.0f / DM) + NORM_EPS); }
template <bool HAS_CS, bool HAS_SS> struct EpiScaleBf16 {
    static constexpr bool PERM = true, AFTER_DRAIN = false, HALO = false, HB2 = false, ABLK = false;
    bf16_t* O; int ldc, coff; const float* cscale; const float* ss;
    __device__ __forceinline__ void operator()(const f32x4 (&acc)[2][2][4][2], const Unit& u, int wr, int wc, int fr, int fq) const {
        const int row0 = u.pm * BM + wr * 64 + fr, col0 = u.pn * BM + wc * 32 + 8 * fq;
        float rs[2][4]; f32x4 cs[2][2];
#pragma unroll
        for (int ai = 0; ai < 2; ++ai)
#pragma unroll
            for (int m = 0; m < 4; ++m) rs[ai][m] = HAS_SS ? ss[row0 + ai * HALF + m * 16] : 1.f;
#pragma unroll
        for (int bj = 0; bj < 2; ++bj)
#pragma unroll
            for (int n = 0; n < 2; ++n) cs[bj][n] = HAS_CS ? *(const f32x4*)(cscale + col0 + bj * HALF + 4 * n) : (f32x4){1.f, 1.f, 1.f, 1.f};
#pragma unroll
        for (int ai = 0; ai < 2; ++ai)
#pragma unroll
            for (int m = 0; m < 4; ++m) {
                const int row = row0 + ai * HALF + m * 16;
                const float r = HAS_SS ? rs_of(rs[ai][m]) : 1.f;
#pragma unroll
                for (int bj = 0; bj < 2; ++bj) {
                    f32x4 v0 = acc[ai][bj][m][0], v1 = acc[ai][bj][m][1];
                    if (HAS_CS) { v0 = v0 * cs[bj][0]; v1 = v1 * cs[bj][1]; }
                    if (HAS_SS) { v0 = v0 * r; v1 = v1 * r; }
                    u32x4 w; w.x = cvt_pk_bf16(v0[0], v0[1]); w.y = cvt_pk_bf16(v0[2], v0[3]); w.z = cvt_pk_bf16(v1[0], v1[1]); w.w = cvt_pk_bf16(v1[2], v1[3]);
                    *(u32x4*)(O + (size_t)row * ldc + coff + col0 + bj * HALF) = w;
                }
            }
    }
};
template <bool HB> struct EpiResid {
    static constexpr bool PERM = false, AFTER_DRAIN = false, HALO = false, HB2 = false, ABLK = false;
    const float* base; float* out; bf16_t* hb; float* ss;
    __device__ __forceinline__ void operator()(const f32x4 (&acc)[2][2][4][2], const Unit& u, int wr, int wc, int fr, int fq) const {
        const int row0 = u.pm * BM + wr * 64 + fr, col0 = u.pn * BM + wc * 32 + 4 * fq;
#pragma unroll
        for (int ai = 0; ai < 2; ++ai) {
            f32x4 b[4][2][2];
#pragma unroll
            for (int m = 0; m < 4; ++m)
#pragma unroll
                for (int bj = 0; bj < 2; ++bj)
#pragma unroll
                    for (int n = 0; n < 2; ++n) b[m][bj][n] = *(const f32x4*)(base + (size_t)(row0 + ai * HALF + m * 16) * DM + col0 + bj * HALF + n * 16);
            asm volatile("" ::: "memory");
#pragma unroll
            for (int m = 0; m < 4; ++m) {
                const int row = row0 + ai * HALF + m * 16; const size_t off = (size_t)row * DM + col0; float s = 0.f;
#pragma unroll
                for (int bj = 0; bj < 2; ++bj)
#pragma unroll
                    for (int n = 0; n < 2; ++n) {
                        const f32x4 h = b[m][bj][n] + acc[ai][bj][m][n];
                        *(f32x4*)(out + off + bj * HALF + n * 16) = h;
                        s += (h[0] * h[0] + h[1] * h[1]) + (h[2] * h[2] + h[3] * h[3]);
                        if (HB) { v2u w; w.x = cvt_pk_bf16(h[0], h[1]); w.y = cvt_pk_bf16(h[2], h[3]); *(v2u*)(hb + off + bj * HALF + n * 16) = w; }
                    }
                s += __shfl_xor(s, 16); s += __shfl_xor(s, 32);
                if (fq == 0) atomicAdd(ss + row, s);
            }
            asm volatile("" ::: "memory");
        }
    }
};
template <bool FIRST> struct EpiResidBf {
    static constexpr bool PERM = true, AFTER_DRAIN = false, HALO = false, HB2 = false, ABLK = !FIRST;
    const float* x; bf16_t* hb; float* ss;
    __device__ __forceinline__ void operator()(const f32x4 (&acc)[2][2][4][2], const Unit& u, int wr, int wc, int fr, int fq) const {
        const int row0 = u.pm * BM + wr * 64 + fr, col0 = u.pn * BM + wc * 32 + 8 * fq;
#pragma unroll
        for (int ai = 0; ai < 2; ++ai) {
            f32x4 bx0[4][2], bx1[4][2]; u32x4 bh[4][2];
#pragma unroll
            for (int m = 0; m < 4; ++m)
#pragma unroll
                for (int bj = 0; bj < 2; ++bj) { const int tk = row0 + ai * HALF + m * 16; const size_t off = (size_t)tk * DM + col0 + bj * HALF;
                    if (FIRST) { bx0[m][bj] = *(const f32x4*)(x + off); bx1[m][bj] = *(const f32x4*)(x + off + 4); }
                    else bh[m][bj] = *(const u32x4*)(hb + blk_off(hb_row(tk), col0 + bj * HALF, DM)); }
            asm volatile("" ::: "memory");
#pragma unroll
            for (int m = 0; m < 4; ++m) {
                const int row = row0 + ai * HALF + m * 16, hr = hb_row(row); const bool dup = FIRST && (row % 254 >= 252); float s = 0.f;
#pragma unroll
                for (int bj = 0; bj < 2; ++bj) {
                    f32x4 h0, h1;
                    if (FIRST) { h0 = bx0[m][bj]; h1 = bx1[m][bj]; }
                    else { const u32x4 q = bh[m][bj]; h0 = (f32x4){__uint_as_float(q.x << 16), __uint_as_float(q.x & 0xffff0000u), __uint_as_float(q.y << 16), __uint_as_float(q.y & 0xffff0000u)};
                           h1 = (f32x4){__uint_as_float(q.z << 16), __uint_as_float(q.z & 0xffff0000u), __uint_as_float(q.w << 16), __uint_as_float(q.w & 0xffff0000u)}; }
                    h0 = h0 + acc[ai][bj][m][0]; h1 = h1 + acc[ai][bj][m][1];
                    s += ((h0[0] * h0[0] + h0[1] * h0[1]) + (h0[2] * h0[2] + h0[3] * h0[3])) + ((h1[0] * h1[0] + h1[1] * h1[1]) + (h1[2] * h1[2] + h1[3] * h1[3]));
                    u32x4 w; w.x = cvt_pk_bf16(h0[0], h0[1]); w.y = cvt_pk_bf16(h0[2], h0[3]); w.z = cvt_pk_bf16(h1[0], h1[1]); w.w = cvt_pk_bf16(h1[2], h1[3]);
                    *(u32x4*)(hb + blk_off(hr, col0 + bj * HALF, DM)) = w;
                    if (dup) *(u32x4*)(hb + blk_off(hr + 2, col0 + bj * HALF, DM)) = w;
                }
                s += __shfl_xor(s, 16); s += __shfl_xor(s, 32);
                if (fq == 0) atomicAdd(ss + row, s);
            }
            asm volatile("" ::: "memory");
        }
    }
};
struct EpiUpConv {
    static constexpr bool PERM = true, AFTER_DRAIN = false, HALO = false, HB2 = false, ABLK = false;
    bf16_t* H; const bf16_t* G; const float* cw; const float* cb; const float* ss;
    __device__ __forceinline__ void operator()(const f32x4 (&acc)[2][2][4][2], const Unit& u, int wr, int wc, int fr, int fq) const {
        const int row0 = u.pm * BM + wr * 64 + fr, col0 = u.pn * BM + wc * 32 + 8 * fq;
        float rs[2][4];
#pragma unroll
        for (int ai = 0; ai < 2; ++ai)
#pragma unroll
            for (int m = 0; m < 4; ++m) rs[ai][m] = ss[row0 + ai * HALF + m * 16];
#pragma unroll
        for (int bj = 0; bj < 2; ++bj) {
            const int col = col0 + bj * HALF;
            float w0[8], w1[8], w2[8], bb[8];
#pragma unroll
            for (int q = 0; q < 2; ++q) { const f32x4 a = *(const f32x4*)(cw + col + 4 * q), b = *(const f32x4*)(cw + DFF + col + 4 * q), c = *(const f32x4*)(cw + 2 * DFF + col + 4 * q), d = *(const f32x4*)(cb + col + 4 * q);
#pragma unroll
                for (int j = 0; j < 4; ++j) { w0[4 * q + j] = a[j]; w1[4 * q + j] = b[j]; w2[4 * q + j] = c[j]; bb[4 * q + j] = d[j]; } }
#pragma unroll
            for (int aim = 0; aim < 4; ++aim) { const int ai = aim >> 1, mb = (aim & 1) * 2;
                u32x4 g0[4], g1[4], g2[4];
#pragma unroll
                for (int m = mb; m < mb + 2; ++m) {
                    const int row = row0 + ai * HALF + m * 16, t = row & (SEQ - 1);
                    const bf16_t* gp = G + (size_t)row * DFF + col;
                    g0[m] = *(const u32x4*)gp;
                    g1[m] = *(const u32x4*)(gp - (t >= 1 ? DFF : 0));
                    g2[m] = *(const u32x4*)(gp - (t >= 2 ? 2 * DFF : 0));
                    if (t < 1) g1[m] = (u32x4){0u, 0u, 0u, 0u};
                    if (t < 2) g2[m] = (u32x4){0u, 0u, 0u, 0u};
                }
                asm volatile("" ::: "memory");
#pragma unroll
                for (int m = mb; m < mb + 2; ++m) {
                    const int row = row0 + ai * HALF + m * 16;
                    const float r = rs_of(rs[ai][m]);
                    float up[8]; { const f32x4 a0 = acc[ai][bj][m][0] * r, a1 = acc[ai][bj][m][1] * r; up[0] = a0[0]; up[1] = a0[1]; up[2] = a0[2]; up[3] = a0[3]; up[4] = a1[0]; up[5] = a1[1]; up[6] = a1[2]; up[7] = a1[3]; }
                    float hv[8];
#pragma unroll
                    for (int j = 0; j < 8; ++j) {
                        const unsigned a = g0[m][j >> 1], b = g1[m][j >> 1], c = g2[m][j >> 1];
                        const float x0 = (j & 1) ? __uint_as_float(a & 0xffff0000u) : __uint_as_float(a << 16);
                        const float x1 = (j & 1) ? __uint_as_float(b & 0xffff0000u) : __uint_as_float(b << 16);
                        const float x2 = (j & 1) ? __uint_as_float(c & 0xffff0000u) : __uint_as_float(c << 16);
                        const float cv = bb[j] + w0[j] * x2 + w1[j] * x1 + w2[j] * x0;
                        const float sg = __builtin_amdgcn_rcpf(1.0f + __expf(-cv));
                        hv[j] = cv * sg * up[j];
                    }
                    u32x4 w; w.x = cvt_pk_bf16(hv[0], hv[1]); w.y = cvt_pk_bf16(hv[2], hv[3]); w.z = cvt_pk_bf16(hv[4], hv[5]); w.w = cvt_pk_bf16(hv[6], hv[7]);
                    *(u32x4*)(H + (size_t)row * DFF + col) = w;
                }
                asm volatile("" ::: "memory");
            }
        }
    }
};
__device__ __forceinline__ float dpp_ror1(float v) { return __builtin_bit_cast(float, __builtin_amdgcn_update_dpp(0, __builtin_bit_cast(int, v), 0x121, 0xF, 0xF, false)); }
__device__ __forceinline__ float dpp_ror2(float v) { return __builtin_bit_cast(float, __builtin_amdgcn_update_dpp(0, __builtin_bit_cast(int, v), 0x122, 0xF, 0xF, false)); }
struct EpiGateUp {
    static constexpr bool PERM = true, AFTER_DRAIN = false, HALO = true, HB2 = true, ABLK = false;
    bf16_t* H; const float* cw; const float* cb; const float* ss; LAS float* X;
    __device__ __forceinline__ void operator()(const f32x4 (&acc)[2][2][4][2], const Unit& u, int wr, int wc, int fr, int fq) const {
        const int T0 = 254 * u.pm - 2, tokb = T0 + wr * 128 + fr, col = u.pn * 128 + wc * 32 + 8 * fq;
        float r[8];
#pragma unroll
        for (int k = 0; k < 8; ++k) { int tc = tokb + 16 * k; tc = tc < 0 ? 0 : (tc > M - 1 ? M - 1 : tc); r[k] = ss[tc]; }
        float w0[8], w1[8], w2[8], bb[8];
#pragma unroll
        for (int q = 0; q < 2; ++q) { const f32x4 a = *(const f32x4*)(cw + col + 4 * q), b = *(const f32x4*)(cw + DFF + col + 4 * q), c = *(const f32x4*)(cw + 2 * DFF + col + 4 * q), d = *(const f32x4*)(cb + col + 4 * q);
#pragma unroll
            for (int j = 0; j < 4; ++j) { w0[4 * q + j] = a[j]; w1[4 * q + j] = b[j]; w2[4 * q + j] = c[j]; bb[4 * q + j] = d[j]; } }
        LAS float* xw = X + wc * 64 + 8 * fq;
        if (wr == 0 && fr >= 14) { const float rr = rs_of(r[7]);
#pragma unroll
            for (int n = 0; n < 2; ++n)
#pragma unroll
                for (int j = 0; j < 4; ++j) xw[(fr - 14) * 32 + 4 * n + j] = acc[1][0][3][n][j] * rr; }
        asm volatile("s_waitcnt lgkmcnt(0)" ::: "memory"); __builtin_amdgcn_s_barrier(); asm volatile("" ::: "memory");
        float s1p[8], s2p[8];
#pragma unroll
        for (int j = 0; j < 8; ++j) { const float pa = (wr == 1) ? xw[j] : 0.f, pb = (wr == 1) ? xw[32 + j] : 0.f; s1p[j] = pb; s2p[j] = (fr == 0) ? pa : pb; }
#pragma unroll
        for (int k = 0; k < 8; ++k) { const int ai = k >> 2, m = k & 3;
            const float rr = rs_of(r[k]); const int tok = tokb + 16 * k, t = tok & (SEQ - 1);
            float gv[8], hv[8];
#pragma unroll
            for (int j = 0; j < 8; ++j) gv[j] = acc[ai][0][m][j >> 2][j & 3] * rr;
            const bool seqstart = __any(t < 2);
#pragma unroll
            for (int j = 0; j < 8; ++j) {
                const float s1 = dpp_ror1(gv[j]), s2 = dpp_ror2(gv[j]);
                float x1 = (fr == 0) ? s1p[j] : s1, x2 = (fr < 2) ? s2p[j] : s2;
                s1p[j] = s1; s2p[j] = s2;
                if (seqstart) { if (t < 1) x1 = 0.f; if (t < 2) x2 = 0.f; }
                const float cv = __builtin_fmaf(w2[j], gv[j], __builtin_fmaf(w1[j], x1, __builtin_fmaf(w0[j], x2, bb[j])));
                const float e = __builtin_amdgcn_exp2f(cv * -1.4426950408889634f);
                hv[j] = cv * __builtin_amdgcn_rcpf(1.0f + e) * (acc[ai][1][m][j >> 2][j & 3] * rr);
            }
            if (tok >= T0 + 2 && tok < M) { u32x4 w; w.x = cvt_pk_bf16(hv[0], hv[1]); w.y = cvt_pk_bf16(hv[2], hv[3]); w.z = cvt_pk_bf16(hv[4], hv[5]); w.w = cvt_pk_bf16(hv[6], hv[7]);
                *(u32x4*)(H + blk_off(tok, col, DFF)) = w; }
        }
    }
};
struct PoolOrder {
    int G, c;
    __device__ bool next(int i, Unit& u) const { const int L = i * G + c; if (L >= 512) return false; u.pm = L & 63; u.pn = L >> 6; u.ka = (u.pn >> 1) * 512 * 2; return true; }
    __device__ __forceinline__ void a_ready(const Unit&) const {}
    __device__ __forceinline__ void done(const Unit&) const {}
};
}

template <bool ILV = false, bool ADJW = false> __device__ __forceinline__ void transpose_item(const float* W, int N, const float* gk, bf16* WT, int ldt, int row_off, int item, int lane) {
    const int nblk = N / 64, kb = item / nblk, nb = item % nblk, k0 = 64 * kb + 8 * (lane >> 3), n0 = 64 * nb + 4 * (lane & 7);
    f32x4 v[2][8];
#pragma unroll
    for (int h = 0; h < 2; ++h)
#pragma unroll
        for (int j = 0; j < 8; ++j) v[h][j] = *(const f32x4*)(W + (size_t)(k0 + j) * N + n0 + 32 * h);
    if (gk) { const f32x4 g0 = *(const f32x4*)(gk + k0), g1 = *(const f32x4*)(gk + k0 + 4);
#pragma unroll
        for (int h = 0; h < 2; ++h)
#pragma unroll
            for (int j = 0; j < 4; ++j) { v[h][j] = v[h][j] * g0[j]; v[h][4 + j] = v[h][4 + j] * g1[j]; } }
#pragma unroll
    for (int h = 0; h < 2; ++h)
#pragma unroll
        for (int i = 0; i < 4; ++i) {
            v4u o; o.x = pk2(v[h][0][i], v[h][1][i]); o.y = pk2(v[h][2][i], v[h][3][i]); o.z = pk2(v[h][4][i], v[h][5][i]); o.w = pk2(v[h][6][i], v[h][7][i]);
            const int n = n0 + 32 * h + i, nrow = ILV ? (((n >> 7) << 8) + (n & 127) + row_off) : (row_off + n);
            const int c32 = nrow & 31, inv32 = ((((c32 >> 2) & 1) << 4) | ((c32 >> 3) << 2) | (c32 & 3));
            const int srow = ADJW ? ((nrow & ~255) + (((nrow >> 5) & 1) << 7) + (((nrow >> 6) & 3) << 5) + inv32) : ((nrow & ~31) + inv32);
            *(v4u*)(WT + ((size_t)(srow >> 4) * (ldt >> 5) + (k0 >> 5)) * 512 + (srow & 15) * 32 + (k0 & 31)) = o; }
}

__device__ __forceinline__ attn::BlockRef<attn::bf16, attn::bf16> attn_ref(int idx, int bx, int G, const bf16* Qb, const bf16* Kb, const bf16* Vb, bf16* O0, bf16* O1) {
    using ABf = attn::bf16;
    const int i = idx >> 1, pass = idx & 1; const int L = bx + G * i, xcd = L & 7, k = L >> 3;
    const int gi = xcd * 8 + (k >> 4), r = k & 15, vh = r >> 3, y = r & 7;
    const int b = gi >> 4, h = (gi >> 1) & 7, c = gi & 1; const int qb = pass ? 15 - y : y;
    attn::BlockRef<ABf, ABf> br;
    br.Q = (const ABf*)Qb + ((size_t)b * SEQ + (size_t)qb * 256) * 2048 + (h * 2 + c) * 128;
    br.K = (const ABf*)Kb + ((size_t)b * SEQ) * 2048 + (h * 2 + c) * 128;
    br.V = (const ABf*)Vb + ((size_t)b * SEQ) * 2048 + h * 256 + vh * 128;
    br.O = (ABf*)(c ? O1 : O0) + ((size_t)b * SEQ + (size_t)qb * 256) * 2048 + h * 256 + vh * 128;
    br.P0 = qb * 256; return br;
}

#define XB_TMO      128
#define XB_XCNT(j)  (256  + 64 * (j))
#define XB_XSUB(j)  (1280 + 64 * (j))
#define XB_XGEN(j)  (2304 + 64 * (j))
#define XB_TOP      3328
#define XB_TOPGEN   3392
#define XCD_BAR_WORDS 3456
#define XB_SPIN_CAP (1u << 18)

__device__ __forceinline__ unsigned xb_ld(unsigned* p)              { return __hip_atomic_load(p, __ATOMIC_RELAXED, __HIP_MEMORY_SCOPE_AGENT); }
__device__ __forceinline__ unsigned xb_add(unsigned* p, unsigned v) { return __hip_atomic_fetch_add(p, v, __ATOMIC_RELAXED, __HIP_MEMORY_SCOPE_AGENT); }
__device__ __forceinline__ unsigned xb_xcc_id() { return (unsigned)__builtin_amdgcn_s_getreg((3 << 11) | 20) & 0xFu; }
#define XB_SPIN(cond, bar) do { unsigned _sp = 0; while (cond) { __builtin_amdgcn_s_sleep(1); \
    if ((++_sp & 255u) == 0u) { if (xb_ld(&(bar)[XB_TMO])) break; if (_sp > XB_SPIN_CAP) { atomicAdd(&(bar)[XB_TMO], 1u); break; } } } } while (0)

struct XcdBarrier {
    unsigned* bar; unsigned x;
    volatile LAS unsigned* st;
};

__device__ __forceinline__ XcdBarrier xcd_barrier_post(unsigned* bar, volatile LAS unsigned* st) {
    XcdBarrier b; b.bar = bar; b.x = xb_xcc_id(); b.st = st;
    if (threadIdx.x == 0) (void)xb_add(&bar[XB_XCNT(b.x)], 1u);
    return b;
}
__device__ __forceinline__ void xcd_barrier_complete(unsigned* bar, unsigned x, unsigned& nloc, unsigned& nx) {
    const unsigned G = gridDim.x * gridDim.y * gridDim.z;
    unsigned sum, cnt, mine, sp = 0u;
    for (;;) {
        sum = 0u; cnt = 0u; mine = 0u;
#pragma unroll
        for (unsigned j = 0; j < 16; ++j) { const unsigned c = xb_ld(&bar[XB_XCNT(j)]); sum += c; cnt += (c > 0u) ? 1u : 0u; mine = (j == x) ? c : mine; }
        if (sum == G) break;
        __builtin_amdgcn_s_sleep(1);
        if ((++sp & 255u) == 0u) { if (xb_ld(&bar[XB_TMO])) break; if (sp > XB_SPIN_CAP) { atomicAdd(&bar[XB_TMO], 1u); break; } }
    }
    nloc = mine > 0u ? mine : 1u; nx = cnt > 0u ? cnt : 1u;
}

__device__ __forceinline__ void xcd_barrier(const XcdBarrier& b) {
    asm volatile("s_waitcnt vmcnt(0)" ::: "memory");
    __syncthreads();
    if (threadIdx.x == 0) {
        unsigned* bar = b.bar;
        __builtin_amdgcn_s_waitcnt(0);
        unsigned nloc = b.st[0], nx = b.st[1];
        if (nloc == 0u) { xcd_barrier_complete(bar, b.x, nloc, nx); b.st[0] = nloc; b.st[1] = nx; }
        const unsigned old = xb_add(&bar[XB_XSUB(b.x)], 1u);
        const unsigned gen = old / nloc;
        if (old + 1u == (gen + 1u) * nloc) {
            __builtin_amdgcn_fence(__ATOMIC_RELEASE, "agent");
            asm volatile("s_waitcnt vmcnt(0)" ::: "memory");
            const unsigned og = xb_add(&bar[XB_TOP], 1u);
            const unsigned tg = og / nx;
            if (og + 1u == (tg + 1u) * nx) xb_add(&bar[XB_TOPGEN], 1u);
            else XB_SPIN(xb_ld(&bar[XB_TOPGEN]) == tg, bar);
            __builtin_amdgcn_fence(__ATOMIC_ACQUIRE, "agent");
            xb_add(&bar[XB_XGEN(b.x)], 1u);
            asm volatile("s_waitcnt vmcnt(0)" ::: "memory");
        } else {
            XB_SPIN(xb_ld(&bar[XB_XGEN(b.x)]) == gen, bar);
            __builtin_amdgcn_fence(__ATOMIC_ACQUIRE, "agent");
            asm volatile("s_waitcnt vmcnt(0)" ::: "memory");
        }
    }
    __syncthreads();
}

struct Args { const float* in[19]; float* out; unsigned char* ws; };

__global__ void __launch_bounds__(NTHREADS, 2) mk_fwd(Args a) {
    extern __shared__ __attribute__((aligned(16))) unsigned char lds[];
    cg::grid_group grid = cg::this_grid();
    LAS unsigned char* ldsl = (LAS unsigned char*)lds;
    const int G = gridDim.x, bx = blockIdx.x;
    const int vcu = (G % 8 == 0) ? (bx % 8) * (G / 8) + bx / 8 : bx;
    const int NGW = G * NWAVES, NGT = NGW * 64;
#define THREAD_IDS() const int tid = pg8::mk_tid(), lane = tid & 63, wave = __builtin_amdgcn_readfirstlane(tid >> 6), gw = vcu * NWAVES + wave, gt = gw * 64 + lane; (void)gt; LAS float* scr = (LAS float*)(ldsl + wave * 16384); (void)scr
    unsigned char* ws = a.ws;
    volatile LAS unsigned* bar_st = (volatile LAS unsigned*)(ldsl + 131072 + 512);
    if (threadIdx.x < 2) bar_st[threadIdx.x] = 0u;
    __syncthreads();
    const XcdBarrier bar = xcd_barrier_post((unsigned*)(ws + WS_BAR), bar_st);
    const float* x = a.in[0]; const int* positions = (const int*)a.in[1]; const float* norm1_g = a.in[2]; const float* w_in = a.in[3];
    const float* lq1 = a.in[4]; const float* lk1 = a.in[5]; const float* lq2 = a.in[6]; const float* lk2 = a.in[7];
    const float* subln_g = a.in[8]; const float* w_pool = a.in[9]; const float* pool_scale = a.in[10]; const float* w_out = a.in[11];
    const float* norm2_g = a.in[12]; const float* w_gate = a.in[13]; const float* w_up = a.in[14]; const float* conv_w = a.in[15];
    const float* conv_b = a.in[16]; const float* w_down = a.in[17]; const float* norm_f_g = a.in[18];
    float* out = a.out;
    float* SS1 = (float*)(ws + WS_SS1); float* SS2 = (float*)(ws + WS_SS2); float* COS = (float*)(ws + WS_COS); float* SIN = (float*)(ws + WS_SIN);
    bf16* Wgate_t = (bf16*)(ws + WS_WGATE); bf16* Wup_t = (bf16*)(ws + WS_WUP); bf16* Wdown_t = (bf16*)out;
    bf16* HB = (bf16*)(ws + WS_HB); bf16* GATE = (bf16*)(ws + WS_GATE); bf16* HID = (bf16*)(ws + WS_HID);
    bf16* Win_t = (bf16*)(ws + WS_WIN); bf16* Wout_t = (bf16*)(ws + WS_WOUT); bf16* Wpool_t = (bf16*)(ws + WS_WPOOL);
    bf16* N1 = (bf16*)(ws + WS_N1); bf16* MIX = (bf16*)(ws + WS_N1);
    bf16* Qb = (bf16*)(ws + WS_Q); bf16* Kb = (bf16*)(ws + WS_K); bf16* Vb = (bf16*)(ws + WS_V); bf16* Ub = (bf16*)(ws + WS_U);
    bf16* POOLED = (bf16*)(ws + WS_POOLED); bf16* O0 = (bf16*)(ws + WS_O0); bf16* O1 = (bf16*)(ws + WS_O1);

    {
        THREAD_IDS();
        constexpr int I_IN = (DM / 64) * (INW / 64), I_OUT = (DM / 64) * (DM / 64), I_G = (DM / 64) * (DFF / 64), I_P = 4 * (512 / 64) * (512 / 64);
        constexpr int I_D = (DFF / 64) * (DM / 64);
        constexpr int NITEMS = I_IN + I_OUT + 2 * I_G + I_D + I_P;
        for (int it = gw; it < NITEMS; it += NGW) {
            int r = it;
            if (r < I_IN) { transpose_item<false, true>(w_in, INW, nullptr, Win_t, DM, 0, r, lane); continue; } r -= I_IN;
            if (r < I_OUT) { transpose_item(w_out, DM, nullptr, Wout_t, DM, 0, r, lane); continue; } r -= I_OUT;
            if (r < I_G) { transpose_item<true>(w_gate, DFF, norm2_g, Wgate_t, DM, 0, r, lane); continue; } r -= I_G;
            if (r < I_G) { transpose_item<true>(w_up, DFF, norm2_g, Wgate_t, DM, 128, r, lane); continue; } r -= I_G;
            if (r < I_D) { transpose_item(w_down, DM, nullptr, Wdown_t, DFF, 0, r, lane); continue; } r -= I_D;
            { const int g = r / (I_P / 4), rr = r % (I_P / 4); transpose_item(w_pool + (size_t)g * 512 * 512, 512, nullptr, Wpool_t, 512, g * 512, rr, lane); }
        }
        for (int m = gw; m < M; m += NGW) {
            const f32x4* xr = (const f32x4*)(x + (size_t)m * DM) + lane;
            f32x4 v[16]; float s = 0.f;
#pragma unroll
            for (int j = 0; j < 16; ++j) { v[j] = xr[64 * j]; s += (v[j].x * v[j].x + v[j].y * v[j].y) + (v[j].z * v[j].z + v[j].w * v[j].w); }
            const float rinv = 1.0f / sqrtf(wave_sum(s) * (1.0f / DM) + NORM_EPS);
            v2u* o8 = (v2u*)(N1 + (size_t)m * DM) + lane;
#pragma unroll
            for (int j = 0; j < 16; ++j) { const f32x4 g = ((const f32x4*)norm1_g)[lane + 64 * j]; v2u w; w.x = pk2(v[j].x * rinv * g.x, v[j].y * rinv * g.y); w.y = pk2(v[j].z * rinv * g.z, v[j].w * rinv * g.w); o8[64 * j] = w; }
        }
        for (int idx = gt; idx < M * 16; idx += NGT) {
            const int m = idx >> 4, i = idx & 15;
            const float inv = exp2f(-(float)i * (18.931568569324174f / 16.0f));
            const float ang = (float)positions[m] * inv;
            COS[idx] = cosf(ang); SIN[idx] = sinf(ang);
        }
        for (int idx = gt; idx < M; idx += NGT) { SS1[idx] = 0.f; SS2[idx] = 0.f; }
    }
    if (a.ws == nullptr) grid.sync();
    xcd_barrier(bar);

    {
        pg8::Gemm g{N1, Win_t, M, INW, DM, DM, DM}; pg8::StaticOrder S; S.init(M, INW, G, bx);
        pg8::EpiQKVU E{Qb, COS, SIN};
        pg8::gemm_phase<pg8::EpiQKVU, pg8::StaticOrder, true, true>(ldsl, g, S, E);
    }
    xcd_barrier(bar);

    {
        THREAD_IDS();
        for (int task = gt; task < (M / 32) * 256; task += NGT) {
            const int ct = task & 255, rc = task >> 8, c0 = ct * 8, m0 = rc * 32, t0 = m0 & (SEQ - 1);
            const int w = 2 << (ct >> 6);
            float sum[8];
#pragma unroll
            for (int j = 0; j < 8; ++j) sum[j] = 0.f;
            for (int i = 1; i < w; ++i) {
                if (t0 - i >= 0) { const v4u q = *(const v4u*)(Ub + (size_t)(m0 - i) * 2048 + c0);
#pragma unroll
                    for (int j = 0; j < 4; ++j) { sum[2 * j] += bflo(q[j]); sum[2 * j + 1] += bfhi(q[j]); } }
            }
            for (int r = 0; r < 32; ++r) {
                const int t = t0 + r; const v4u q = *(const v4u*)(Ub + (size_t)(m0 + r) * 2048 + c0);
                float cur[8];
#pragma unroll
                for (int j = 0; j < 4; ++j) { cur[2 * j] = bflo(q[j]); cur[2 * j + 1] = bfhi(q[j]); }
#pragma unroll
                for (int j = 0; j < 8; ++j) sum[j] += cur[j];
                const float ic = 1.0f / (float)((t + 1 < w) ? (t + 1) : w);
                v4u pw;
#pragma unroll
                for (int j = 0; j < 4; ++j) pw[j] = pk2(sum[2 * j] * ic - cur[2 * j], sum[2 * j + 1] * ic - cur[2 * j + 1]);
                *(v4u*)(POOLED + (size_t)(m0 + r) * 2048 + c0) = pw;
                if (t - w + 1 >= 0) { const v4u o = *(const v4u*)(Ub + (size_t)(m0 + r - w + 1) * 2048 + c0);
#pragma unroll
                    for (int j = 0; j < 4; ++j) { sum[2 * j] -= bflo(o[j]); sum[2 * j + 1] -= bfhi(o[j]); } }
            }
        }
        __syncthreads();
        if (bx < 1024) {
            using ABf = attn::bf16; typedef attn::BlockRef<ABf, ABf> BR;
            const int nblk = 2 * ((1024 - bx + G - 1) / G);
            attn::Seam<ABf> S;
            BR cur = attn_ref(0, bx, G, Qb, Kb, Vb, O0, O1);
            attn::causal_swa_prime<ABf, ABf>(cur, SEQ, (char*)lds, S);
            for (int idx = 0; idx < nblk; ++idx) {
                const BR nxt = (idx == nblk - 1) ? cur : attn_ref(idx + 1, bx, G, Qb, Kb, Vb, O0, O1);
                attn::causal_swa_block<ABf, ABf>(cur, nxt, SEQ, SEQ, (char*)lds, S);
                cur = nxt;
            }
        }
    }
    xcd_barrier(bar);

    {
        {
            pg8::Gemm g{POOLED, Wpool_t, M, PW, 512, 2048, 512}; pg8::PoolOrder S{G, bx};
            pg8::EpiScaleBf16<true, false> E{MIX, DM, AW, pool_scale, nullptr};
            pg8::gemm_phase<pg8::EpiScaleBf16<true, false>, pg8::PoolOrder, true, true>(ldsl, g, S, E);
        }
        THREAD_IDS();
        float lam;
        { const float s1 = wave_sum(lq1[lane] * lk1[lane] + lq1[lane + 64] * lk1[lane + 64]), s2 = wave_sum(lq2[lane] * lk2[lane] + lq2[lane + 64] * lk2[lane + 64]);
          lam = expf(s1) - expf(s2) + 0.2f; }
        const int l32 = lane & 31, e0 = l32 * 8;
        float sg[8];
#pragma unroll
        for (int j = 0; j < 8; ++j) sg[j] = subln_g[e0 + j] * 0.8f;
        for (int p = gw * 2 + (lane >> 5); p < M * NHEAD; p += NGW * 2) {
            const int m = p >> 3, h = p & 7; const size_t off = (size_t)m * 2048 + h * 256 + e0;
            const v4u a0 = *(const v4u*)(O0 + off), a1 = *(const v4u*)(O1 + off);
            float d[8]; float ssq = 0.f;
#pragma unroll
            for (int j = 0; j < 4; ++j) { d[2 * j] = bflo(a0[j]) - lam * bflo(a1[j]); d[2 * j + 1] = bfhi(a0[j]) - lam * bfhi(a1[j]); ssq += d[2 * j] * d[2 * j] + d[2 * j + 1] * d[2 * j + 1]; }
#pragma unroll
            for (int o = 1; o < 32; o <<= 1) ssq += __shfl_xor(ssq, o);
            const float rinv = 1.0f / sqrtf(ssq * (1.0f / 256.0f) + SUBLN_EPS);
            v4u w;
#pragma unroll
            for (int j = 0; j < 4; ++j) w[j] = pk2(d[2 * j] * rinv * sg[2 * j], d[2 * j + 1] * rinv * sg[2 * j + 1]);
            *(v4u*)(MIX + (size_t)m * DM + h * 256 + e0) = w;
        }
    }
    xcd_barrier(bar);

    {
        pg8::Gemm g{MIX, Wout_t, M, DM, DM, DM, DM}; pg8::StaticOrder S; S.init(M, DM, G, bx);
        pg8::EpiResidBf<true> E{x, HB, SS1};
        pg8::gemm_phase<pg8::EpiResidBf<true>, pg8::StaticOrder, true, true>(ldsl, g, S, E);
    }
    xcd_barrier(bar);

    {
        pg8::Gemm g{HB, Wgate_t, 65 * 256, 2 * DFF, DM, DM, DM}; pg8::StaticOrder S; S.init(65 * 256, 2 * DFF, G, bx);
        pg8::EpiGateUp E{HID, conv_w, conv_b, SS1, (LAS float*)(ldsl + 131072 + 1024)};
        pg8::gemm_phase<pg8::EpiGateUp, pg8::StaticOrder, true, true>(ldsl, g, S, E);
    }
    xcd_barrier(bar);

    {
        pg8::Gemm g{HID, Wdown_t, M, DM, DFF, DFF, DFF}; pg8::StaticOrder S; S.init(M, DM, G, bx);
        pg8::EpiResidBf<false> E{nullptr, HB, SS2};
        pg8::gemm_phase<pg8::EpiResidBf<false>, pg8::StaticOrder, true, true>(ldsl, g, S, E);
    }
    xcd_barrier(bar);

    { THREAD_IDS();
    for (int m = gw; m < M; m += NGW) {
        const int hrw = hb_row(m); f32x4* orow = (f32x4*)(out + (size_t)m * DM) + 2 * lane;
        const float rinv = 1.0f / sqrtf(SS2[m] * (1.0f / DM) + NORM_EPS);
        v4u q[8];
#pragma unroll
        for (int j = 0; j < 8; ++j) q[j] = *(const v4u*)(HB + blk_off(hrw, 8 * (lane + 64 * j), DM));
#pragma unroll
        for (int j = 0; j < 8; ++j) { const f32x4 g0 = ((const f32x4*)norm_f_g)[2 * lane + 128 * j], g1 = ((const f32x4*)norm_f_g)[2 * lane + 128 * j + 1];
            orow[128 * j] = (f32x4){bflo(q[j].x), bfhi(q[j].x), bflo(q[j].y), bfhi(q[j].y)} * rinv * g0;
            orow[128 * j + 1] = (f32x4){bflo(q[j].z), bfhi(q[j].z), bflo(q[j].w), bfhi(q[j].w)} * rinv * g1; }
    } }
}

extern "C" void kernel_launch(void* const* d_in, const int* in_sizes, int n_in, void* d_out, int out_size, void* d_ws, size_t ws_size, hipStream_t stream) {
    static int grid = 0;
    if (grid == 0) {
        if (n_in != 19 || out_size != M * DM || ws_size < WS_END) { fprintf(stderr, "kernel_launch: unexpected shapes n_in %d out %d ws %zu\n", n_in, out_size, ws_size); grid = -1; return; }
        int dev = 0, cus = 0, per_cu = 0;
        (void)hipGetDevice(&dev);
        (void)hipDeviceGetAttribute(&cus, hipDeviceAttributeMultiprocessorCount, dev);
        if (hipFuncSetAttribute((const void*)mk_fwd, hipFuncAttributeMaxDynamicSharedMemorySize, LDS_BYTES) != hipSuccess) { fprintf(stderr, "kernel_launch: hipFuncSetAttribute failed\n"); grid = -1; return; }
        if (hipOccupancyMaxActiveBlocksPerMultiprocessor(&per_cu, (const void*)mk_fwd, NTHREADS, LDS_BYTES) != hipSuccess || per_cu < 1) { fprintf(stderr, "kernel_launch: occupancy query says %d\n", per_cu); per_cu = 1; }
        (void)hipGetLastError();
        grid = cus * per_cu;
        fprintf(stderr, "kernel_launch: grid %d (cus %d x %d)\n", grid, cus, per_cu);
    }
    if (grid < 0) return;
    if (hipMemsetAsync((char*)d_ws + WS_BAR, 0, WS_BAR_BYTES, stream) != hipSuccess) { fprintf(stderr, "kernel_launch: memset of the barrier words failed\n"); return; }
    Args a{};
    for (int i = 0; i < 19; ++i) a.in[i] = (const float*)d_in[i];
    a.out = (float*)d_out; a.ws = (unsigned char*)d_ws;
    void* args[] = {&a};
    hipError_t e = hipLaunchCooperativeKernel((const void*)mk_fwd, dim3(grid), dim3(NTHREADS), args, LDS_BYTES, stream);
    if (e != hipSuccess) fprintf(stderr, "kernel_launch: cooperative launch failed: %s (grid %d)\n", hipGetErrorString(e), grid);
}
```

```cpp
#include <hip/hip_runtime.h>
#include <hip/hip_bf16.h>
#include <hip/hip_cooperative_groups.h>
#include <cstdio>
#include <cstdint>
namespace pg8 { __device__ __forceinline__ int mk_tid() { int t = threadIdx.x; asm volatile("" : "+v"(t)); return t; } }
namespace pg8 {
#define PG8_LAS __attribute__((address_space(3)))
typedef unsigned short bf16_t;
typedef short bf16x8 __attribute__((ext_vector_type(8)));
typedef float f32x4 __attribute__((ext_vector_type(4)));
typedef unsigned u32x4 __attribute__((ext_vector_type(4)));
constexpr int BM = 256, BK = 64, HALF = 128, HTB = HALF * BK * 2  , STAGE_BYTES = 8 * HTB, NXCD = 8, WGM = 8;

__host__ __device__ __forceinline__ int lds_byte(int r, int c) { const int st = (r >> 4) * 2 + (c >> 5), rr = r & 15, cc = c & 31, ob = rr * 64 + cc * 2; return st * 1024 + (ob ^ (((ob >> 9) & 1) << 5)); }
__host__ __device__ __forceinline__ void stage_rc(int b, int& R, int& C) { const int st = b / 1024, sb = b % 1024, swz = sb ^ (((sb >> 9) & 1) << 5); R = (st >> 1) * 16 + swz / 64; C = (st & 1) * 32 + (swz % 64) / 2; }
__host__ __device__ __forceinline__ int perm32(int rho) { const int n = rho >> 4, i = rho & 15; return 8 * (i >> 2) + 4 * n + (i & 3); }

struct Unit { int pm, pn, ka; };
struct Gemm { const bf16_t* A; const bf16_t* Bt; int M, N, K, lda, ldb; };
struct StaticOrder {
    int nM, nN, nwg, G, c;
    __host__ __device__ void init(int M, int N, int G_, int c_) { nM = M / BM; nN = N / BM; nwg = nM * nN; G = G_; c = c_; }
    __host__ __device__ bool next(int i, Unit& u) const {
        const long L = (long)i * G + c; if (L >= nwg) return false;
        int wgid = (int)L; { const int q = nwg / NXCD, r = nwg % NXCD, xcd = wgid % NXCD, off = wgid / NXCD; wgid = (xcd < r ? xcd * (q + 1) : r * (q + 1) + (xcd - r) * q) + off; }
        const int nig = WGM * nN, gid = wgid / nig, fm = gid * WGM, gsz = (nM - fm) < WGM ? (nM - fm) : WGM;
        u.pm = fm + ((wgid % nig) % gsz); u.pn = (wgid % nig) / gsz; u.ka = 0; return true;
    }
    __device__ __forceinline__ void a_ready(const Unit&) const {}
    __device__ __forceinline__ void done(const Unit&) const {}
};
__device__ __forceinline__ unsigned cvt_pk_bf16(float lo, float hi) { unsigned r; asm volatile("v_cvt_pk_bf16_f32 %0, %1, %2" : "=v"(r) : "v"(lo), "v"(hi)); return r; }
template <class Epi, class Sched, bool ALIGN_EPI = false, bool SP2 = false>
__device__ __forceinline__ void gemm_phase(PG8_LAS unsigned char* lds, const Gemm g, const Sched& S, const Epi& E) {
    const int tid = mk_tid(), wid = __builtin_amdgcn_readfirstlane(tid >> 6), lane = tid & 63, wr = wid >> 2, wc = wid & 3, fr = lane & 15, fq = lane >> 4;
    const int K = g.K, nt = K / BK;
    unsigned voffA[2], voffB[2];
#pragma unroll
    for (int i = 0; i < 2; ++i) { int R, C; stage_rc(tid * 16 + i * 8192, R, C); const int Rb = Epi::PERM ? ((R & ~31) + perm32(R & 31)) : R;
        voffA[i] = Epi::HB2 ? (unsigned)((((R >> 6) * 8 + ((R & 63) >> 4)) * (g.lda >> 5) + (C >> 5)) * 1024 + (R & 15) * 64 + (C & 31) * 2) : Epi::ABLK ? (unsigned)(((R >> 4) * (g.lda >> 5) + (C >> 5)) * 1024 + (R & 15) * 64 + (C & 31) * 2) : (unsigned)((Epi::HALO ? ((R >> 6) * 128 + (R & 63)) : R) * g.lda + C) * 2u; voffB[i] = (unsigned)(((R >> 4) * (g.ldb >> 5) + (C >> 5)) * 1024 + (R & 15) * 64 + (C & 31) * 2); static_assert(Epi::PERM, "blocked weights are stored in PERM slot order"); }
    const size_t kstep = (Epi::HB2 || Epi::ABLK) ? (size_t)2048 : (size_t)(BK * 2), kstepB = 2048;
    const size_t hstepA = (size_t)(Epi::HALO ? 64 : HALF) * g.lda * 2, hstepB = (size_t)HALF * g.ldb * 2;
    const size_t tstepA = (size_t)((Epi::HALO && !Epi::HB2) ? 254 : BM) * g.lda * 2, tstepB = 2 * hstepB;
    const unsigned ldsw = (unsigned)wid * 1024u;
    const int aoff = lds_byte(wr * 64 + fr, fq * 8), boff = lds_byte(wc * 32 + fr, fq * 8);
#define PG8_SA(b, h) (((b) * 2 + (h)) * HTB)
#define PG8_SB(b, h) ((4 + (b) * 2 + (h)) * HTB)
#define PG8_STAGE(bufoff, gbase, voff) do { _Pragma("unroll") for (int _i = 0; _i < 2; ++_i) \
        __builtin_amdgcn_global_load_lds((const unsigned*)((const char*)(gbase) + (voff)[_i]), (PG8_LAS unsigned*)(lds + (bufoff) + ldsw + _i * 8192), 16, 0, 0); } while (0)
#define PG8_LDA(dst, b, h) do { _Pragma("unroll") for (int m = 0; m < 4; ++m) _Pragma("unroll") for (int k = 0; k < 2; ++k) dst[m][k] = *(const PG8_LAS bf16x8*)(lds + PG8_SA(b, h) + aoff + m * 2048 + k * 1024); } while (0)
#define PG8_LDB(dst, b, h) do { _Pragma("unroll") for (int n = 0; n < 2; ++n) _Pragma("unroll") for (int k = 0; k < 2; ++k) dst[n][k] = *(const PG8_LAS bf16x8*)(lds + PG8_SB(b, h) + boff + n * 2048 + k * 1024); } while (0)
#define PG8_MMA(ai, bj, At, Bt) do { __builtin_amdgcn_s_setprio(1); _Pragma("unroll") for (int m = 0; m < 4; ++m) _Pragma("unroll") for (int n = 0; n < 2; ++n) _Pragma("unroll") for (int k = 0; k < 2; ++k) \
        acc[ai][bj][m][n] = __builtin_amdgcn_mfma_f32_16x16x32_bf16(Bt[n][k], At[m][k], acc[ai][bj][m][n], 0, 0, 0); __builtin_amdgcn_s_setprio(0); } while (0)
#define PG8_WAIT_V(n) asm volatile("s_waitcnt vmcnt(" #n ")" ::: "memory")
#define PG8_WAIT_L(n) asm volatile("s_waitcnt lgkmcnt(" #n ")" ::: "memory")
#define PG8_BAR __builtin_amdgcn_s_barrier()
#define PG8_SCHED __builtin_amdgcn_sched_barrier(0)
    Unit cur, nxt; int ui = 0;
    if (!S.next(0, cur)) return;
    f32x4 acc[2][2][4][2];
#pragma unroll
    for (int a = 0; a < 2; ++a)
#pragma unroll
        for (int b = 0; b < 2; ++b)
#pragma unroll
            for (int m = 0; m < 4; ++m)
#pragma unroll
                for (int n = 0; n < 2; ++n) acc[a][b][m][n] = (f32x4){0.f, 0.f, 0.f, 0.f};
    bf16x8 At[4][2], B0[2][2], B1[2][2];
    const char* cA = (const char*)g.A + (size_t)cur.pm * tstepA + cur.ka; const char* cB = (const char*)g.Bt + (size_t)cur.pn * tstepB;
    S.a_ready(cur);
    if constexpr (SP2) {
        PG8_STAGE(PG8_SB(0, 0), cB, voffB); PG8_STAGE(PG8_SB(0, 1), cB + hstepB, voffB); PG8_STAGE(PG8_SA(0, 0), cA, voffA); PG8_STAGE(PG8_SA(0, 1), cA + hstepA, voffA);
        if (wr == 1) PG8_BAR;
        PG8_WAIT_V(2); PG8_BAR;
        PG8_STAGE(PG8_SB(1, 0), cB + kstepB, voffB); PG8_STAGE(PG8_SA(1, 0), cA + kstep, voffA); PG8_STAGE(PG8_SB(1, 1), cB + hstepB + kstepB, voffB);
        PG8_WAIT_V(6); PG8_BAR;
    } else {
        PG8_STAGE(PG8_SB(0, 0), cB, voffB); PG8_STAGE(PG8_SA(0, 0), cA, voffA); PG8_STAGE(PG8_SB(0, 1), cB + hstepB, voffB); PG8_STAGE(PG8_SA(0, 1), cA + hstepA, voffA);
        if (wr == 1) PG8_BAR;
        PG8_WAIT_V(4); PG8_BAR;
        PG8_STAGE(PG8_SB(1, 0), cB + kstepB, voffB); PG8_STAGE(PG8_SA(1, 0), cA + kstep, voffA); PG8_STAGE(PG8_SB(1, 1), cB + hstepB + kstepB, voffB);
        PG8_WAIT_V(6); PG8_BAR;
    }
    for (;;) {
        const bool has_next = S.next(ui + 1, nxt);
        const char* nA = has_next ? (const char*)g.A + (size_t)nxt.pm * tstepA + nxt.ka : cA; const char* nB = has_next ? (const char*)g.Bt + (size_t)nxt.pn * tstepB : cB;
        for (int t = 0; t < nt; t += 2) {
            const bool last = (t == nt - 2);
            const char* a1 = cA + (size_t)(t + 1) * kstep;
            const char* a2 = last ? nA : cA + (size_t)(t + 2) * kstep; const char* b2 = last ? nB : cB + (size_t)(t + 2) * kstepB;
            const char* a3 = a2 + kstep; const char* b3 = b2 + kstepB;
            if (last && has_next) S.a_ready(nxt);
            if constexpr (SP2) {
            PG8_LDB(B0, 0, 0); PG8_LDB(B1, 0, 1); PG8_SCHED; PG8_LDA(At, 0, 0); PG8_STAGE(PG8_SA(1, 1), a1 + hstepA, voffA);
            PG8_WAIT_V(8); PG8_WAIT_L(0); PG8_BAR; PG8_MMA(0, 0, At, B0); PG8_MMA(0, 1, At, B1); PG8_BAR; PG8_SCHED;
            PG8_LDA(At, 0, 1); PG8_STAGE(PG8_SB(0, 0), b2, voffB); PG8_STAGE(PG8_SB(0, 1), b2 + hstepB, voffB); PG8_STAGE(PG8_SA(0, 0), a2, voffA);
            PG8_WAIT_V(8); PG8_WAIT_L(0); PG8_BAR; PG8_MMA(1, 0, At, B0); PG8_MMA(1, 1, At, B1); PG8_BAR; PG8_SCHED;
            PG8_LDB(B0, 1, 0); PG8_LDB(B1, 1, 1); PG8_SCHED; PG8_LDA(At, 1, 0); PG8_STAGE(PG8_SA(0, 1), a2 + hstepA, voffA);
            PG8_WAIT_V(8); PG8_WAIT_L(0); PG8_BAR; PG8_MMA(0, 0, At, B0); PG8_MMA(0, 1, At, B1); PG8_BAR; PG8_SCHED;
            PG8_LDA(At, 1, 1); PG8_STAGE(PG8_SB(1, 0), b3, voffB); PG8_STAGE(PG8_SB(1, 1), b3 + hstepB, voffB); PG8_STAGE(PG8_SA(1, 0), a3, voffA);
            PG8_WAIT_V(8); PG8_WAIT_L(0); PG8_BAR; PG8_MMA(1, 0, At, B0); PG8_MMA(1, 1, At, B1); PG8_BAR; PG8_SCHED;
            } else {
            PG8_LDB(B0, 0, 0); PG8_SCHED; PG8_LDA(At, 0, 0); PG8_STAGE(PG8_SA(1, 1), a1 + hstepA, voffA);
            PG8_WAIT_L(8); PG8_BAR; PG8_WAIT_L(0); PG8_MMA(0, 0, At, B0); PG8_BAR; PG8_SCHED;
            PG8_LDB(B1, 0, 1); PG8_STAGE(PG8_SB(0, 0), b2, voffB);
            PG8_BAR; PG8_WAIT_L(0); PG8_MMA(0, 1, At, B1); PG8_BAR;
            PG8_LDA(At, 0, 1); PG8_STAGE(PG8_SA(0, 0), a2, voffA);
            PG8_BAR; PG8_WAIT_L(0); PG8_MMA(1, 0, At, B0); PG8_BAR; PG8_SCHED;
            PG8_STAGE(PG8_SB(0, 1), b2 + hstepB, voffB);
            PG8_WAIT_V(6); PG8_BAR; PG8_MMA(1, 1, At, B1); PG8_BAR;
            PG8_LDB(B0, 1, 0); PG8_SCHED; PG8_LDA(At, 1, 0); PG8_STAGE(PG8_SA(0, 1), a2 + hstepA, voffA);
            PG8_WAIT_L(8); PG8_BAR; PG8_WAIT_L(0); PG8_MMA(0, 0, At, B0); PG8_BAR; PG8_SCHED;
            PG8_LDB(B1, 1, 1); PG8_STAGE(PG8_SB(1, 0), b3, voffB);
            PG8_BAR; PG8_WAIT_L(0); PG8_MMA(0, 1, At, B1); PG8_BAR;
            PG8_LDA(At, 1, 1); PG8_STAGE(PG8_SA(1, 0), a3, voffA);
            PG8_BAR; PG8_WAIT_L(0); PG8_MMA(1, 0, At, B0); PG8_BAR; PG8_SCHED;
            PG8_STAGE(PG8_SB(1, 1), b3 + hstepB, voffB);
            PG8_WAIT_V(6); PG8_BAR; PG8_MMA(1, 1, At, B1); PG8_BAR;
            }
        }
        if constexpr (ALIGN_EPI) { if (wr == 0) PG8_BAR; }
        if constexpr (!Epi::AFTER_DRAIN) { E(acc, cur, wr, wc, fr, fq); S.done(cur); }
        if (!has_next) break;
#pragma unroll
        for (int a = 0; a < 2; ++a)
#pragma unroll
            for (int b = 0; b < 2; ++b)
#pragma unroll
                for (int m = 0; m < 4; ++m)
#pragma unroll
                    for (int n = 0; n < 2; ++n) acc[a][b][m][n] = (f32x4){0.f, 0.f, 0.f, 0.f};
        cur = nxt; cA = nA; cB = nB; ++ui;
        if constexpr (ALIGN_EPI) { if (wr == 1) PG8_BAR; }
    }
    PG8_WAIT_V(0);
    if constexpr (!ALIGN_EPI) { if (wr == 0) PG8_BAR; }
    PG8_BAR;
    if constexpr (Epi::AFTER_DRAIN) { E.fused(acc, cur, wr, wc, fr, fq, lds, wid, lane); S.done(cur); }
#undef PG8_SA
#undef PG8_SB
#undef PG8_STAGE
#undef PG8_LDA
#undef PG8_LDB
#undef PG8_MMA
#undef PG8_WAIT_V
#undef PG8_WAIT_L
#undef PG8_BAR
#undef PG8_SCHED
}
}
namespace attn {
constexpr int D = 128, PITCH = 2048;
constexpr float THR = 8.f;
constexpr bool WSKIP = false;
constexpr float SCALE = 0.08838834764831845f;
constexpr int NW = 8, QBLK = 32, KVBLK = 64, QB = NW * QBLK;
constexpr int SHM_V = KVBLK * D * 2, SHM_K = KVBLK * D * 2;
constexpr int LDS_BYTES = 2 * SHM_V + 2 * SHM_K + NW * 64 * 4;
using bf16 = __hip_bfloat16;
typedef short bf16x8 __attribute__((ext_vector_type(8)));
typedef short s16x4 __attribute__((ext_vector_type(4)));
typedef float f32x16 __attribute__((ext_vector_type(16)));
typedef float f32x4 __attribute__((ext_vector_type(4)));
typedef unsigned u32x4 __attribute__((ext_vector_type(4)));
template <class A, class Bt> struct same_t { static constexpr bool v = false; };
template <class A> struct same_t<A, A> { static constexpr bool v = true; };

#define KSWZ(row, colB) ((row) * 256 + ((colB) ^ (((row) & 7) << 4)))
#define SBAR() __builtin_amdgcn_sched_barrier(0)
__device__ __forceinline__ int v_st(int k, int c) { const int kk = (k & ~0xC) | ((k & 4) << 1) | ((k & 8) >> 1); return ((kk >> 3) * 4 + (c >> 5)) * 512 + ((kk & 7) * 32 + (c & 31)) * 2; }
__device__ __forceinline__ int v_rd_base(int lane) { return ((lane & 3) << 3) | (((lane >> 2) & 3) << 6) | (((lane >> 4) & 1) << 5) | (((lane >> 5) & 1) << 8); }
constexpr int v_rd_off(int d0, int ks, int half) { return d0 * 512 + ks * 4096 + half * 2048; }
__device__ __forceinline__ int crow(int r, int hi) { return (r & 3) + 8 * (r >> 2) + 4 * hi; }
__device__ __forceinline__ unsigned cvtpk(float lo, float hi) {
    unsigned r; asm volatile("v_cvt_pk_bf16_f32 %0, %1, %2" : "=v"(r) : "v"(lo), "v"(hi)); return r;
}
__device__ __forceinline__ bf16x8 pack8(f32x4 a, f32x4 b) {
    u32x4 w = {cvtpk(a[0], a[1]), cvtpk(a[2], a[3]), cvtpk(b[0], b[1]), cvtpk(b[2], b[3])};
    return *reinterpret_cast<bf16x8*>(&w);
}
template <class T> __device__ __forceinline__ bf16x8 load8(const T* p) {
    if constexpr (same_t<T, float>::v) { return pack8(*(const f32x4*)p, *(const f32x4*)(p + 4)); }
    else { return *reinterpret_cast<const bf16x8*>(p); }
}
__device__ __forceinline__ void mask_tile(f32x16& p0, f32x16& p1, int dq, unsigned W) {
    const float NEG = -__builtin_inff();
#pragma unroll
    for (int r = 0; r < 16; ++r) {
        const int c = (r & 3) + 8 * (r >> 2);
        if ((unsigned)(dq - c) >= W) p0[r] = NEG;
        if ((unsigned)(dq - c - 32) >= W) p1[r] = NEG;
    }
}
__device__ __forceinline__ void partialSM(f32x16& p0, f32x16& p1, float& m_reg, float& mn, float& alpha) {
    float pmax = p0[0]; for (int r = 1; r < 16; ++r) pmax = fmaxf(pmax, p0[r]); for (int r = 0; r < 16; ++r) pmax = fmaxf(pmax, p1[r]);
    { auto rr = __builtin_amdgcn_permlane32_swap(__float_as_uint(pmax), __float_as_uint(pmax), false, false);
      pmax = fmaxf(__uint_as_float(rr[0]), __uint_as_float(rr[1])); }
    constexpr float C2 = 1.4426950408889634f * SCALE;
    if (__builtin_expect(__all((pmax - m_reg) * SCALE <= THR), 1)) { mn = m_reg; alpha = 1.f; }
    else { mn = fmaxf(m_reg, pmax); alpha = __builtin_amdgcn_exp2f((m_reg - mn) * C2); m_reg = mn; }
    const float mnL = -mn * C2;
    for (int r = 0; r < 16; ++r) p0[r] = fmaf(p0[r], C2, mnL); for (int r = 0; r < 16; ++r) p1[r] = fmaf(p1[r], C2, mnL);
    for (int r = 0; r < 16; ++r) p0[r] = __builtin_amdgcn_exp2f(p0[r]);
}
__device__ __forceinline__ void finishSM(f32x16& p0, f32x16& p1, float alpha, float& l_reg, bf16x8& pa0, bf16x8& pa1, bf16x8& pa2, bf16x8& pa3) {
    for (int r = 0; r < 16; ++r) p1[r] = __builtin_amdgcn_exp2f(p1[r]);
    float ps = 0; for (int r = 0; r < 16; ++r) ps += p0[r]; for (int r = 0; r < 16; ++r) ps += p1[r];
    { auto rr = __builtin_amdgcn_permlane32_swap(__float_as_uint(ps), __float_as_uint(ps), false, false);
      ps = __uint_as_float(rr[0]) + __uint_as_float(rr[1]); }
    l_reg = l_reg * alpha + ps;
#define PK4(P, B_, OUT) do { unsigned a0 = cvtpk(P[B_+0], P[B_+1]), a1 = cvtpk(P[B_+2], P[B_+3]);                          \
        unsigned b0 = cvtpk(P[B_+4], P[B_+5]), b1 = cvtpk(P[B_+6], P[B_+7]);                                             \
        auto r0 = __builtin_amdgcn_permlane32_swap(a0, b0, false, false); auto r1 = __builtin_amdgcn_permlane32_swap(a1, b1, false, false); \
        u32x4 w = {r0[0], r1[0], r0[1], r1[1]}; OUT = *reinterpret_cast<bf16x8*>(&w); } while (0)
    PK4(p0, 0, pa0); PK4(p0, 8, pa1); PK4(p1, 0, pa2); PK4(p1, 8, pa3);
#undef PK4
}
template <int KB, bool SK>
__device__ __forceinline__ void qkt(f32x16& p0, f32x16& p1, const char* K_lds, int r32, int hi, const bf16x8* qr, bool act) {
    if (SK && !act) { const float NEG = -__builtin_inff();
#pragma unroll
        for (int r = 0; r < 16; ++r) { p0[r] = NEG; p1[r] = NEG; } return; }
    p0 = f32x16{}; p1 = f32x16{};
    const char* kb[4];
#pragma unroll
    for (int dd = 0; dd < 4; ++dd) kb[dd] = K_lds + KB * SHM_K + KSWZ(r32, (dd * 16 + hi * 8) * 2);
#pragma unroll
    for (int d0 = 0; d0 < 8; ++d0) { const char* a = kb[d0 & 3] + (d0 >> 2) * 128;
        bf16x8 b0 = *reinterpret_cast<const bf16x8*>(a);
        bf16x8 b1 = *reinterpret_cast<const bf16x8*>(a + 32 * 256);
        p0 = __builtin_amdgcn_mfma_f32_32x32x16_bf16(b0, qr[d0], p0, 0, 0, 0);
        p1 = __builtin_amdgcn_mfma_f32_32x32x16_bf16(b1, qr[d0], p1, 0, 0, 0); }
}
template <int VB, bool SK>
__device__ __forceinline__ void pv_tile(f32x16* o, int vb0, bf16x8 pa0, bf16x8 pa1, bf16x8 pa2, bf16x8 pa3, bool act) {
    if (SK && !act) return;
#define TRRD(dst, off) asm volatile("ds_read_b64_tr_b16 %0, %1 offset:%2" : "=&v"(dst) : "v"(vb0), "i"(off) : "memory")
#define PV_D0(d0) do { s16x4 l0, l1, l2, l3, h0, h1, h2, h3; constexpr int b_ = VB * SHM_V + v_rd_off(d0, 0, 0);     \
        TRRD(l0, b_); TRRD(h0, b_ + 2048); TRRD(l1, b_ + 4096); TRRD(h1, b_ + 6144); TRRD(l2, b_ + 8192); TRRD(h2, b_ + 10240); TRRD(l3, b_ + 12288); TRRD(h3, b_ + 14336); \
        asm volatile("s_waitcnt lgkmcnt(0)" ::: "memory"); SBAR();                 \
        o[d0] = __builtin_amdgcn_mfma_f32_32x32x16_bf16(pa0, (bf16x8){l0[0], l0[1], l0[2], l0[3], h0[0], h0[1], h0[2], h0[3]}, o[d0], 0, 0, 0);   \
        o[d0] = __builtin_amdgcn_mfma_f32_32x32x16_bf16(pa1, (bf16x8){l1[0], l1[1], l1[2], l1[3], h1[0], h1[1], h1[2], h1[3]}, o[d0], 0, 0, 0);   \
        o[d0] = __builtin_amdgcn_mfma_f32_32x32x16_bf16(pa2, (bf16x8){l2[0], l2[1], l2[2], l2[3], h2[0], h2[1], h2[2], h2[3]}, o[d0], 0, 0, 0);   \
        o[d0] = __builtin_amdgcn_mfma_f32_32x32x16_bf16(pa3, (bf16x8){l3[0], l3[1], l3[2], l3[3], h3[0], h3[1], h3[2], h3[3]}, o[d0], 0, 0, 0); } while (0)
    PV_D0(0); PV_D0(1); PV_D0(2); PV_D0(3);
#undef PV_D0
#undef TRRD
}

template <class TIn, class TOut> struct BlockRef { const TIn* Q; const TIn* K; const TIn* V; TOut* O; int P0; };
template <class TIn> struct Seam {
    bf16x8 qr[8];
    bf16x8 st_v0, st_v1, st_k0, st_k1; f32x4 sf0, sf1, sf2, sf3;
    f32x4 tq[16];
};
__device__ __forceinline__ int swa_jlo(int P0, int W) { const int lowk = P0 - W + 1; return lowk > 0 ? lowk / KVBLK : 0; }
#define ROW(p, k0, rr) ((p) + (size_t)((k0) + (rr)) * PITCH + sc)
#define VMW() asm volatile("s_waitcnt vmcnt(0)" ::: "memory")
#define VMWN(n) asm volatile("s_waitcnt vmcnt(%0)" :: "i"(n) : "memory")
#define SLOAD_H(Kp, Vp, k0) do { S.st_v0 = load8<TIn>(ROW(Vp, k0, sr)); S.st_v1 = load8<TIn>(ROW(Vp, k0, 32 + sr));              \
                         S.st_k0 = load8<TIn>(ROW(Kp, k0, sr)); S.st_k1 = load8<TIn>(ROW(Kp, k0, 32 + sr)); } while (0)
#define SWRITE_HK(bf) do { *(bf16x8*)(K_lds + (bf) * SHM_K + kws) = S.st_k0; *(bf16x8*)(K_lds + (bf) * SHM_K + kws + 32 * 256) = S.st_k1; } while (0)
#define SWRITE_HV(bf) do { *(bf16x8*)(V_lds + (bf) * SHM_V + vst0) = S.st_v0; *(bf16x8*)(V_lds + (bf) * SHM_V + vst1) = S.st_v1; } while (0)
#define SWRITE_H(bf) do { SWRITE_HV(bf); SWRITE_HK(bf); } while (0)
#define SLOAD_F(p, k0) do { S.sf0 = *(const f32x4*)ROW(p, k0, sr); S.sf1 = *(const f32x4*)(ROW(p, k0, sr) + 4);                \
                            S.sf2 = *(const f32x4*)ROW(p, k0, 32 + sr); S.sf3 = *(const f32x4*)(ROW(p, k0, 32 + sr) + 4); } while (0)
#define SWRITE_KF(bf) do { *(bf16x8*)(K_lds + (bf) * SHM_K + kws) = pack8(S.sf0, S.sf1); *(bf16x8*)(K_lds + (bf) * SHM_K + kws + 32 * 256) = pack8(S.sf2, S.sf3); } while (0)
#define SWRITE_VF(bf) do { *(bf16x8*)(V_lds + (bf) * SHM_V + vst0) = pack8(S.sf0, S.sf1); *(bf16x8*)(V_lds + (bf) * SHM_V + vst1) = pack8(S.sf2, S.sf3); } while (0)
template <class TIn, class TOut>
__device__ __forceinline__ void causal_swa_prime(const BlockRef<TIn, TOut>& cur, int W, char* lds, Seam<TIn>& S) {
    constexpr bool F32 = same_t<TIn, float>::v;
    const int tid = pg8::mk_tid(), wid = __builtin_amdgcn_readfirstlane(tid >> 6), lane = tid & 63, r32 = lane & 31, hi = lane >> 5;
    const int sr = tid >> 4, sc = (tid & 15) * 8, kws = KSWZ(sr, sc * 2); char* K_lds = lds + 2 * SHM_V;
    const int kb0 = swa_jlo(cur.P0, W) * KVBLK;
    for (int d0 = 0; d0 < 8; ++d0) S.qr[d0] = load8<TIn>(cur.Q + (size_t)(wid * QBLK + r32) * PITCH + d0 * 16 + hi * 8);
    if constexpr (F32) { SLOAD_F((const float*)cur.K, kb0); VMW(); SWRITE_KF(0); SBAR(); SLOAD_F((const float*)cur.V, kb0); }
    else { SLOAD_H(cur.K, cur.V, kb0); VMW(); SWRITE_HK(0); }
    __syncthreads();
}
template <class TIn, class TOut>
__device__ __forceinline__ void causal_swa_block(const BlockRef<TIn, TOut>& cur, const BlockRef<TIn, TOut>& nxt, int skv, int W, char* lds, Seam<TIn>& S) {
    constexpr bool F32 = same_t<TIn, float>::v;
    const int tid = pg8::mk_tid(), wid = __builtin_amdgcn_readfirstlane(tid >> 6), lane = tid & 63, r32 = lane & 31, hi = lane >> 5;
    const int j_lo = swa_jlo(cur.P0, W);
    int j_hi = (cur.P0 + QB - 1) / KVBLK + 1; if (j_hi > skv / KVBLK) j_hi = skv / KVBLK;
    const int NT = j_hi - j_lo;
    const int kbn = swa_jlo(nxt.P0, W) * KVBLK;
    const int qlo = cur.P0 + wid * QBLK, qm = qlo + r32 - 4 * hi;
    char* V_lds = lds; char* K_lds = lds + 2 * SHM_V;
    float* ws = (float*)(lds + 2 * SHM_V + 2 * SHM_K) + wid * 64; float* li_l = ws, * al_l = ws + 32;
    float m_reg = -1e30f, l_reg = 0; f32x16 o[4] = {};
    const int sr = tid >> 4, sc = (tid & 15) * 8, vst0 = v_st(sr, sc), vst1 = v_st(32 + sr, sc), kws = KSWZ(sr, sc * 2);
    const int vb0 = (int)(uintptr_t)V_lds + v_rd_base(lane);
    const TIn* Kh = cur.K; const TIn* Vh = cur.V;
#define RESC(a) do { if (__any((a) < 1.f)) { if (hi == 0) al_l[r32] = (a); asm volatile("s_waitcnt lgkmcnt(0)" ::: "memory");              \
                     for (int d_ = 0; d_ < 4; ++d_) for (int r = 0; r < 16; ++r) o[d_][r] *= al_l[crow(r, hi)]; } } while (0)
#define KBASE(t) ((j_lo + (t)) * KVBLK)
#define ACT(t) (KBASE(t) <= qlo + QBLK - 1 && KBASE(t) + KVBLK - 1 >= qlo - W + 1)
#define MASKT(P0_, P1_, t) do { const int kb_ = KBASE(t); if ((!SK || ACT(t)) && (kb_ + KVBLK - 1 > qlo || kb_ <= qlo + QBLK - 1 - W)) mask_tile(P0_, P1_, qm - kb_, (unsigned)W); } while (0)
    constexpr int NQL = F32 ? 16 : 8;
    constexpr bool SK = WSKIP && !F32;
#define SEAM_K0() do { VMWN(NQL); if constexpr (F32) { SWRITE_KF(0); SBAR(); SLOAD_F((const float*)nxt.V, kbn); } else { SWRITE_HK(0); } SBAR(); } while (0)
    f32x16 pA0, pA1, pB0, pB1; float mnA, mnB, alA, alB; bf16x8 pa0, pa1, pa2, pa3;
    if constexpr (F32) { VMW(); SWRITE_VF(0); SBAR(); } else { SWRITE_HV(0); SBAR(); }
    if (NT > 1) { if constexpr (F32) SLOAD_F((const float*)Kh, KBASE(1)); else SLOAD_H(Kh, Vh, KBASE(1)); }
    SBAR(); qkt<0, SK>(pA0, pA1, K_lds, r32, hi, S.qr, ACT(0));
    if constexpr (F32) { if (NT > 1) { VMW(); SWRITE_KF(1); SBAR(); SLOAD_F((const float*)Vh, KBASE(1)); } }
    MASKT(pA0, pA1, 0); partialSM(pA0, pA1, m_reg, mnA, alA);
    if (NT > 1) { VMW(); if constexpr (F32) { SWRITE_VF(1); SBAR(); if (NT > 2) SLOAD_F((const float*)Kh, KBASE(2)); } else SWRITE_H(1); }
    __syncthreads();
#define HALF_STEP(PX0, PX1, mnX, alX, PY0, PY1, alY, t, KB, VB, SB) do {                                                      \
        SBAR(); qkt<KB, SK>(PX0, PX1, K_lds, r32, hi, S.qr, ACT(t));                                             \
        finishSM(PY0, PY1, alY, l_reg, pa0, pa1, pa2, pa3); SBAR();                                                           \
        if ((t) + 1 < NT) { if constexpr (F32) { VMW(); SWRITE_KF(SB); SBAR(); SLOAD_F((const float*)Vh, KBASE((t) + 1)); }  \
                            else { SLOAD_H(Kh, Vh, KBASE((t) + 1)); } SBAR(); }                                               \
        pv_tile<VB, SK>(o, vb0, pa0, pa1, pa2, pa3, ACT((t) - 1)); MASKT(PX0, PX1, (t)); partialSM(PX0, PX1, m_reg, mnX, alX);                                        \
        __syncthreads();                                                                                                      \
        if ((t) + 1 < NT) { VMW(); if constexpr (F32) { SWRITE_VF(SB); SBAR(); if ((t) + 2 < NT) SLOAD_F((const float*)Kh, KBASE((t) + 2)); } \
                            else { SWRITE_H(SB); } }                                                                          \
        RESC(alX); __syncthreads(); } while (0)
    for (int t = 1; t + 1 < NT; t += 2) {
        HALF_STEP(pB0, pB1, mnB, alB, pA0, pA1, alA, t, 1, 0, 0);
        HALF_STEP(pA0, pA1, mnA, alA, pB0, pB1, alB, t + 1, 0, 1, 1);
    }
    const bool even = (NT & 1) == 0;
    if (even) { SBAR(); qkt<1, SK>(pB0, pB1, K_lds, r32, hi, S.qr, ACT(NT - 1)); SBAR(); }
#define QROW(e) (nxt.Q + (size_t)(wid * QBLK + r32) * PITCH + ((e) >> 1) * 16 + hi * 8 + ((e) & 1) * 4)
    if constexpr (F32) { SLOAD_F((const float*)nxt.K, kbn); SBAR();
#pragma unroll
        for (int e = 0; e < 8; ++e) S.tq[e] = *(const f32x4*)QROW(e); }
    else { SLOAD_H(nxt.K, nxt.V, kbn); SBAR();
#pragma unroll
        for (int d0 = 0; d0 < 8; ++d0) S.qr[d0] = load8<TIn>(nxt.Q + (size_t)(wid * QBLK + r32) * PITCH + d0 * 16 + hi * 8); }
    SBAR();
    finishSM(pA0, pA1, alA, l_reg, pa0, pa1, pa2, pa3); SBAR();
    if constexpr (F32) {
#pragma unroll
        for (int e = 8; e < 16; ++e) S.tq[e] = *(const f32x4*)QROW(e); SBAR(); }
#undef QROW
    pv_tile<0, SK>(o, vb0, pa0, pa1, pa2, pa3, ACT(even ? NT - 2 : NT - 1));
    if (even) { MASKT(pB0, pB1, NT - 1); partialSM(pB0, pB1, m_reg, mnB, alB); __syncthreads(); RESC(alB);
        finishSM(pB0, pB1, alB, l_reg, pa0, pa1, pa2, pa3); SBAR(); pv_tile<1, SK>(o, vb0, pa0, pa1, pa2, pa3, ACT(NT - 1)); }
    SBAR(); SEAM_K0();
    if (hi == 0) li_l[r32] = l_reg; asm volatile("s_waitcnt lgkmcnt(0)" ::: "memory");
    float rli[16];
#pragma unroll
    for (int r = 0; r < 16; ++r) rli[r] = __builtin_amdgcn_rcpf(li_l[crow(r, hi)]);
    TOut* Ow = cur.O + (size_t)(wid * QBLK) * PITCH;
#pragma unroll
    for (int r = 0; r < 16; ++r) { const int orow = crow(r, hi);
#pragma unroll
        for (int d0 = 0; d0 < 4; ++d0) { const float v = o[d0][r] * rli[r];
            if constexpr (same_t<TOut, float>::v) { Ow[(size_t)orow * PITCH + d0 * 32 + r32] = v; }
            else { const float vn = __shfl_xor(v, 1);
                   if ((r32 & 1) == 0) *(unsigned*)(Ow + (size_t)orow * PITCH + d0 * 32 + r32) = cvtpk(v, vn); } } }
    if constexpr (F32) {
#pragma unroll
        for (int d0 = 0; d0 < 8; ++d0) S.qr[d0] = pack8(S.tq[2 * d0], S.tq[2 * d0 + 1]); }
    __syncthreads();
#undef RESC
#undef KBASE
#undef ACT
#undef MASKT
#undef SEAM_K0
#undef HALF_STEP
}
#undef ROW
#undef VMW
#undef VMWN
#undef SLOAD_H
#undef SWRITE_HK
#undef SWRITE_HV
#undef SWRITE_H
#undef SLOAD_F
#undef SWRITE_KF
#undef SWRITE_VF

}

namespace cg = cooperative_groups;
#define LAS __attribute__((address_space(3)))
typedef unsigned short bf16;
typedef unsigned v4u __attribute__((ext_vector_type(4)));
typedef unsigned v2u __attribute__((ext_vector_type(2)));
typedef float f32x4 __attribute__((ext_vector_type(4)));

constexpr int NB = 4, SEQ = 4096, DM = 4096, M = NB * SEQ, AW = 2048, PW = 2048, INW = 8192, DFF = 11008, NHEAD = 8;
constexpr float NORM_EPS = 1e-5f, SUBLN_EPS = 1e-5f;
constexpr int NWAVES = 8, NTHREADS = 512;
constexpr int LDS_BYTES = 147456;

constexpr size_t MiB = 1u << 20;
constexpr size_t WS_SS1 = 0, WS_SS2 = 64 * 1024;
constexpr size_t WS_BAR = 128 * 1024, WS_BAR_BYTES = 16 * 1024;
constexpr size_t WS_COS = 1 * MiB, WS_SIN = 2 * MiB;
constexpr size_t WS_WGATE = 4 * MiB;
constexpr size_t WS_WUP = 90 * MiB;
constexpr size_t WS_HB = 176 * MiB;
constexpr size_t WS_GATE = 304 * MiB;
constexpr size_t WS_HID = 648 * MiB;
constexpr size_t WS_WIN = 304 * MiB, WS_WOUT = 368 * MiB, WS_WPOOL = 400 * MiB;
constexpr size_t WS_N1 = 402 * MiB;
constexpr size_t WS_Q = 530 * MiB, WS_K = 594 * MiB, WS_V = 658 * MiB, WS_U = 722 * MiB;
constexpr size_t WS_POOLED = 786 * MiB, WS_O0 = 850 * MiB, WS_O1 = 914 * MiB;
constexpr size_t WS_END = 992 * MiB;
static_assert(WS_WGATE + (size_t)DFF * DM * 2 <= WS_WUP && WS_WUP + (size_t)DFF * DM * 2 <= WS_HB && WS_HB + (size_t)65 * 256 * DM * 2 <= WS_WOUT, "ws map 1");
static_assert(WS_GATE + (size_t)M * DFF * 2 <= WS_HID && WS_HID + (size_t)M * DFF * 2 <= WS_END, "ws map 2");
static_assert(WS_O1 + (size_t)M * 2048 * 2 <= WS_END && WS_WIN + (size_t)INW * DM * 2 <= WS_WOUT && WS_WOUT + (size_t)DM * DM * 2 <= WS_WPOOL && WS_WPOOL + 2 * MiB <= WS_N1, "ws map 3");

__device__ __forceinline__ float bf2f(unsigned short b) { return __uint_as_float((unsigned)b << 16); }
__device__ __forceinline__ float bflo(unsigned w) { return __uint_as_float(w << 16); }
__device__ __forceinline__ float bfhi(unsigned w) { return __uint_as_float(w & 0xffff0000u); }
__device__ __forceinline__ unsigned pk2(float lo, float hi) { return pg8::cvt_pk_bf16(lo, hi); }
__device__ __forceinline__ size_t blk_off(int row, int col, int ld) { return ((size_t)(row >> 4) * (ld >> 5) + (col >> 5)) * 512 + (row & 15) * 32 + (col & 31); }
__device__ __forceinline__ int hb_row(int t) { return t + 2 + 2 * (t / 254); }
__device__ __forceinline__ float wave_sum(float v) {
#pragma unroll
    for (int o = 1; o < 64; o <<= 1) v += __shfl_xor(v, o);
    return v;
}

namespace pg8 {
struct EpiQKVU {
    static constexpr bool PERM = true, AFTER_DRAIN = false, HALO = false, HB2 = false, ABLK = false;
    bf16_t* O; const float* cosT; const float* sinT;
    __device__ __forceinline__ void operator()(const f32x4 (&acc)[2][2][4][2], const Unit& u, int wr, int wc, int fr, int fq) const {
        const int t = u.pn >> 3;
        bf16_t* base = O + (size_t)t * ((size_t)M * 2048);
        const int row0 = u.pm * BM + wr * 64 + fr, col0 = (u.pn & 7) * BM + wc * 32 + 8 * fq;
        const bool rope = (t < 2) && (wc == 0);
        const float sgn = (fq < 2) ? -1.f : 1.f;
        if (rope) {
#pragma unroll
            for (int ai = 0; ai < 2; ++ai) {
                f32x4 c0[4], c1[4], s0[4], s1[4];
#pragma unroll
                for (int m = 0; m < 4; ++m) { const size_t ro = (size_t)(row0 + ai * HALF + m * 16) * 16 + 8 * (fq & 1);
                    c0[m] = *(const f32x4*)(cosT + ro); c1[m] = *(const f32x4*)(cosT + ro + 4); s0[m] = *(const f32x4*)(sinT + ro); s1[m] = *(const f32x4*)(sinT + ro + 4); }
                asm volatile("" ::: "memory");
#pragma unroll
                for (int m = 0; m < 4; ++m) {
                    bf16_t* rowp = base + (size_t)(row0 + ai * HALF + m * 16) * 2048 + col0;
                    const f32x4 sa = s0[m] * sgn, sb = s1[m] * sgn;
#pragma unroll
                    for (int bj = 0; bj < 2; ++bj) {
                        f32x4 v0 = acc[ai][bj][m][0], v1 = acc[ai][bj][m][1], p0, p1;
#pragma unroll
                        for (int j = 0; j < 4; ++j) { p0[j] = __shfl_xor(v0[j], 32); p1[j] = __shfl_xor(v1[j], 32); }
                        v0 = v0 * c0[m] + p0 * sa; v1 = v1 * c1[m] + p1 * sb;
                        u32x4 w; w.x = cvt_pk_bf16(v0[0], v0[1]); w.y = cvt_pk_bf16(v0[2], v0[3]); w.z = cvt_pk_bf16(v1[0], v1[1]); w.w = cvt_pk_bf16(v1[2], v1[3]);
                        *(u32x4*)(rowp + bj * HALF) = w;
                    }
                }
                asm volatile("" ::: "memory");
            }
        } else {
#pragma unroll
            for (int ai = 0; ai < 2; ++ai)
#pragma unroll
                for (int m = 0; m < 4; ++m) {
                    bf16_t* rowp = base + (size_t)(row0 + ai * HALF + m * 16) * 2048 + col0;
#pragma unroll
                    for (int bj = 0; bj < 2; ++bj) {
                        const f32x4 v0 = acc[ai][bj][m][0], v1 = acc[ai][bj][m][1];
                        u32x4 w; w.x = cvt_pk_bf16(v0[0], v0[1]); w.y = cvt_pk_bf16(v0[2], v0[3]); w.z = cvt_pk_bf16(v1[0], v1[1]); w.w = cvt_pk_bf16(v1[2], v1[3]);
                        *(u32x4*)(rowp + bj * HALF) = w;
                    }
                }
        }
    }
};
__device__ __forceinline__ float rs_of(float ss) { return __builtin_amdgcn_rsqf(ss * (1.0f / DM) + NORM_EPS); }
template <bool HAS_CS, bool HAS_SS> struct EpiScaleBf16 {
    static constexpr bool PERM = true, AFTER_DRAIN = false, HALO = false, HB2 = false, ABLK = false;
    bf16_t* O; int ldc, coff; const float* cscale; const float* ss;
    __device__ __forceinline__ void operator()(const f32x4 (&acc)[2][2][4][2], const Unit& u, int wr, int wc, int fr, int fq) const {
        const int row0 = u.pm * BM + wr * 64 + fr, col0 = u.pn * BM + wc * 32 + 8 * fq;
        float rs[2][4]; f32x4 cs[2][2];
#pragma unroll
        for (int ai = 0; ai < 2; ++ai)
#pragma unroll
            for (int m = 0; m < 4; ++m) rs[ai][m] = HAS_SS ? ss[row0 + ai * HALF + m * 16] : 1.f;
#pragma unroll
        for (int bj = 0; bj < 2; ++bj)
#pragma unroll
            for (int n = 0; n < 2; ++n) cs[bj][n] = HAS_CS ? *(const f32x4*)(cscale + col0 + bj * HALF + 4 * n) : (f32x4){1.f, 1.f, 1.f, 1.f};
#pragma unroll
        for (int ai = 0; ai < 2; ++ai)
#pragma unroll
            for (int m = 0; m < 4; ++m) {
                const int row = row0 + ai * HALF + m * 16;
                const float r = HAS_SS ? rs_of(rs[ai][m]) : 1.f;
#pragma unroll
                for (int bj = 0; bj < 2; ++bj) {
                    f32x4 v0 = acc[ai][bj][m][0], v1 = acc[ai][bj][m][1];
                    if (HAS_CS) { v0 = v0 * cs[bj][0]; v1 = v1 * cs[bj][1]; }
                    if (HAS_SS) { v0 = v0 * r; v1 = v1 * r; }
                    u32x4 w; w.x = cvt_pk_bf16(v0[0], v0[1]); w.y = cvt_pk_bf16(v0[2], v0[3]); w.z = cvt_pk_bf16(v1[0], v1[1]); w.w = cvt_pk_bf16(v1[2], v1[3]);
                    *(u32x4*)(O + (size_t)row * ldc + coff + col0 + bj * HALF) = w;
                }
            }
    }
};
template <bool HB> struct EpiResid {
    static constexpr bool PERM = false, AFTER_DRAIN = false, HALO = false, HB2 = false, ABLK = false;
    const float* base; float* out; bf16_t* hb; float* ss;
    __device__ __forceinline__ void operator()(const f32x4 (&acc)[2][2][4][2], const Unit& u, int wr, int wc, int fr, int fq) const {
        const int row0 = u.pm * BM + wr * 64 + fr, col0 = u.pn * BM + wc * 32 + 4 * fq;
#pragma unroll
        for (int ai = 0; ai < 2; ++ai) {
            f32x4 b[4][2][2];
#pragma unroll
            for (int m = 0; m < 4; ++m)
#pragma unroll
                for (int bj = 0; bj < 2; ++bj)
#pragma unroll
                    for (int n = 0; n < 2; ++n) b[m][bj][n] = *(const f32x4*)(base + (size_t)(row0 + ai * HALF + m * 16) * DM + col0 + bj * HALF + n * 16);
            asm volatile("" ::: "memory");
#pragma unroll
            for (int m = 0; m < 4; ++m) {
                const int row = row0 + ai * HALF + m * 16; const size_t off = (size_t)row * DM + col0; float s = 0.f;
#pragma unroll
                for (int bj = 0; bj < 2; ++bj)
#pragma unroll
                    for (int n = 0; n < 2; ++n) {
                        const f32x4 h = b[m][bj][n] + acc[ai][bj][m][n];
                        *(f32x4*)(out + off + bj * HALF + n * 16) = h;
                        s += (h[0] * h[0] + h[1] * h[1]) + (h[2] * h[2] + h[3] * h[3]);
                        if (HB) { v2u w; w.x = cvt_pk_bf16(h[0], h[1]); w.y = cvt_pk_bf16(h[2], h[3]); *(v2u*)(hb + off + bj * HALF + n * 16) = w; }
                    }
                s += __shfl_xor(s, 16); s += __shfl_xor(s, 32);
                if (fq == 0) atomicAdd(ss + row, s);
            }
            asm volatile("" ::: "memory");
        }
    }
};
template <bool FIRST> struct EpiResidBf {
    static constexpr bool PERM = true, AFTER_DRAIN = false, HALO = false, HB2 = false, ABLK = !FIRST;
    const float* x; bf16_t* hb; float* ss;
    __device__ __forceinline__ void operator()(const f32x4 (&acc)[2][2][4][2], const Unit& u, int wr, int wc, int fr, int fq) const {
        const int row0 = u.pm * BM + wr * 64 + fr, col0 = u.pn * BM + wc * 32 + 8 * fq;
#pragma unroll
        for (int ai = 0; ai < 2; ++ai) {
            f32x4 bx0[4][2], bx1[4][2]; u32x4 bh[4][2];
#pragma unroll
            for (int m = 0; m < 4; ++m)
#pragma unroll
                for (int bj = 0; bj < 2; ++bj) { const int tk = row0 + ai * HALF + m * 16; const size_t off = (size_t)tk * DM + col0 + bj * HALF;
                    if (FIRST) { bx0[m][bj] = *(const f32x4*)(x + off); bx1[m][bj] = *(const f32x4*)(x + off + 4); }
                    else bh[m][bj] = *(const u32x4*)(hb + blk_off(hb_row(tk), col0 + bj * HALF, DM)); }
            asm volatile("" ::: "memory");
#pragma unroll
            for (int m = 0; m < 4; ++m) {
                const int row = row0 + ai * HALF + m * 16, hr = hb_row(row); const bool dup = FIRST && (row % 254 >= 252); float s = 0.f;
#pragma unroll
                for (int bj = 0; bj < 2; ++bj) {
                    f32x4 h0, h1;
                    if (FIRST) { h0 = bx0[m][bj]; h1 = bx1[m][bj]; }
                    else { const u32x4 q = bh[m][bj]; h0 = (f32x4){__uint_as_float(q.x << 16), __uint_as_float(q.x & 0xffff0000u), __uint_as_float(q.y << 16), __uint_as_float(q.y & 0xffff0000u)};
                           h1 = (f32x4){__uint_as_float(q.z << 16), __uint_as_float(q.z & 0xffff0000u), __uint_as_float(q.w << 16), __uint_as_float(q.w & 0xffff0000u)}; }
                    h0 = h0 + acc[ai][bj][m][0]; h1 = h1 + acc[ai][bj][m][1];
                    s += ((h0[0] * h0[0] + h0[1] * h0[1]) + (h0[2] * h0[2] + h0[3] * h0[3])) + ((h1[0] * h1[0] + h1[1] * h1[1]) + (h1[2] * h1[2] + h1[3] * h1[3]));
                    u32x4 w; w.x = cvt_pk_bf16(h0[0], h0[1]); w.y = cvt_pk_bf16(h0[2], h0[3]); w.z = cvt_pk_bf16(h1[0], h1[1]); w.w = cvt_pk_bf16(h1[2], h1[3]);
                    *(u32x4*)(hb + blk_off(hr, col0 + bj * HALF, DM)) = w;
                    if (dup) *(u32x4*)(hb + blk_off(hr + 2, col0 + bj * HALF, DM)) = w;
                }
                s += __shfl_xor(s, 16); s += __shfl_xor(s, 32);
                if (fq == 0) atomicAdd(ss + row, s);
            }
            asm volatile("" ::: "memory");
        }
    }
};
struct EpiUpConv {
    static constexpr bool PERM = true, AFTER_DRAIN = false, HALO = false, HB2 = false, ABLK = false;
    bf16_t* H; const bf16_t* G; const float* cw; const float* cb; const float* ss;
    __device__ __forceinline__ void operator()(const f32x4 (&acc)[2][2][4][2], const Unit& u, int wr, int wc, int fr, int fq) const {
        const int row0 = u.pm * BM + wr * 64 + fr, col0 = u.pn * BM + wc * 32 + 8 * fq;
        float rs[2][4];
#pragma unroll
        for (int ai = 0; ai < 2; ++ai)
#pragma unroll
            for (int m = 0; m < 4; ++m) rs[ai][m] = ss[row0 + ai * HALF + m * 16];
#pragma unroll
        for (int bj = 0; bj < 2; ++bj) {
            const int col = col0 + bj * HALF;
            float w0[8], w1[8], w2[8], bb[8];
#pragma unroll
            for (int q = 0; q < 2; ++q) { const f32x4 a = *(const f32x4*)(cw + col + 4 * q), b = *(const f32x4*)(cw + DFF + col + 4 * q), c = *(const f32x4*)(cw + 2 * DFF + col + 4 * q), d = *(const f32x4*)(cb + col + 4 * q);
#pragma unroll
                for (int j = 0; j < 4; ++j) { w0[4 * q + j] = a[j]; w1[4 * q + j] = b[j]; w2[4 * q + j] = c[j]; bb[4 * q + j] = d[j]; } }
#pragma unroll
            for (int aim = 0; aim < 4; ++aim) { const int ai = aim >> 1, mb = (aim & 1) * 2;
                u32x4 g0[4], g1[4], g2[4];
#pragma unroll
                for (int m = mb; m < mb + 2; ++m) {
                    const int row = row0 + ai * HALF + m * 16, t = row & (SEQ - 1);
                    const bf16_t* gp = G + (size_t)row * DFF + col;
                    g0[m] = *(const u32x4*)gp;
                    g1[m] = *(const u32x4*)(gp - (t >= 1 ? DFF : 0));
                    g2[m] = *(const u32x4*)(gp - (t >= 2 ? 2 * DFF : 0));
                    if (t < 1) g1[m] = (u32x4){0u, 0u, 0u, 0u};
                    if (t < 2) g2[m] = (u32x4){0u, 0u, 0u, 0u};
                }
                asm volatile("" ::: "memory");
#pragma unroll
                for (int m = mb; m < mb + 2; ++m) {
                    const int row = row0 + ai * HALF + m * 16;
                    const float r = rs_of(rs[ai][m]);
                    float up[8]; { const f32x4 a0 = acc[ai][bj][m][0] * r, a1 = acc[ai][bj][m][1] * r; up[0] = a0[0]; up[1] = a0[1]; up[2] = a0[2]; up[3] = a0[3]; up[4] = a1[0]; up[5] = a1[1]; up[6] = a1[2]; up[7] = a1[3]; }
                    float hv[8];
#pragma unroll
                    for (int j = 0; j < 8; ++j) {
                        const unsigned a = g0[m][j >> 1], b = g1[m][j >> 1], c = g2[m][j >> 1];
                        const float x0 = (j & 1) ? __uint_as_float(a & 0xffff0000u) : __uint_as_float(a << 16);
                        const float x1 = (j & 1) ? __uint_as_float(b & 0xffff0000u) : __uint_as_float(b << 16);
                        const float x2 = (j & 1) ? __uint_as_float(c & 0xffff0000u) : __uint_as_float(c << 16);
                        const float cv = bb[j] + w0[j] * x2 + w1[j] * x1 + w2[j] * x0;
                        const float sg = __builtin_amdgcn_rcpf(1.0f + __expf(-cv));
                        hv[j] = cv * sg * up[j];
                    }
                    u32x4 w; w.x = cvt_pk_bf16(hv[0], hv[1]); w.y = cvt_pk_bf16(hv[2], hv[3]); w.z = cvt_pk_bf16(hv[4], hv[5]); w.w = cvt_pk_bf16(hv[6], hv[7]);
                    *(u32x4*)(H + (size_t)row * DFF + col) = w;
                }
                asm volatile("" ::: "memory");
            }
        }
    }
};
__device__ __forceinline__ float dpp_ror1(float v) { return __builtin_bit_cast(float, __builtin_amdgcn_update_dpp(0, __builtin_bit_cast(int, v), 0x121, 0xF, 0xF, false)); }
__device__ __forceinline__ float dpp_ror2(float v) { return __builtin_bit_cast(float, __builtin_amdgcn_update_dpp(0, __builtin_bit_cast(int, v), 0x122, 0xF, 0xF, false)); }
struct EpiGateUp {
    static constexpr bool PERM = true, AFTER_DRAIN = false, HALO = true, HB2 = true, ABLK = false;
    bf16_t* H; const float* cw; const float* cb; const float* ss; LAS float* X;
    __device__ __forceinline__ void operator()(const f32x4 (&acc)[2][2][4][2], const Unit& u, int wr, int wc, int fr, int fq) const {
        const int T0 = 254 * u.pm - 2, tokb = T0 + wr * 128 + fr, col = u.pn * 128 + wc * 32 + 8 * fq;
        float r[8];
#pragma unroll
        for (int k = 0; k < 8; ++k) { int tc = tokb + 16 * k; tc = tc < 0 ? 0 : (tc > M - 1 ? M - 1 : tc); r[k] = ss[tc]; }
        float w0[8], w1[8], w2[8], bb[8];
#pragma unroll
        for (int q = 0; q < 2; ++q) { const f32x4 a = *(const f32x4*)(cw + col + 4 * q), b = *(const f32x4*)(cw + DFF + col + 4 * q), c = *(const f32x4*)(cw + 2 * DFF + col + 4 * q), d = *(const f32x4*)(cb + col + 4 * q);
#pragma unroll
            for (int j = 0; j < 4; ++j) { w0[4 * q + j] = a[j]; w1[4 * q + j] = b[j]; w2[4 * q + j] = c[j]; bb[4 * q + j] = d[j]; } }
        LAS float* xw = X + wc * 64 + 8 * fq;
        if (wr == 0 && fr >= 14) { const float rr = rs_of(r[7]);
#pragma unroll
            for (int n = 0; n < 2; ++n)
#pragma unroll
                for (int j = 0; j < 4; ++j) xw[(fr - 14) * 32 + 4 * n + j] = acc[1][0][3][n][j] * rr; }
        asm volatile("s_waitcnt lgkmcnt(0)" ::: "memory"); __builtin_amdgcn_s_barrier(); asm volatile("" ::: "memory");
        float s1p[8], s2p[8];
#pragma unroll
        for (int j = 0; j < 8; ++j) { const float pa = (wr == 1) ? xw[j] : 0.f, pb = (wr == 1) ? xw[32 + j] : 0.f; s1p[j] = pb; s2p[j] = (fr == 0) ? pa : pb; }
#pragma unroll
        for (int k = 0; k < 8; ++k) { const int ai = k >> 2, m = k & 3;
            const float rr = rs_of(r[k]); const int tok = tokb + 16 * k, t = tok & (SEQ - 1);
            float gv[8], hv[8];
#pragma unroll
            for (int j = 0; j < 8; ++j) gv[j] = acc[ai][0][m][j >> 2][j & 3] * rr;
            const bool seqstart = __any(t < 2);
#pragma unroll
            for (int j = 0; j < 8; ++j) {
                const float s1 = dpp_ror1(gv[j]), s2 = dpp_ror2(gv[j]);
                float x1 = (fr == 0) ? s1p[j] : s1, x2 = (fr < 2) ? s2p[j] : s2;
                s1p[j] = s1; s2p[j] = s2;
                if (seqstart) { if (t < 1) x1 = 0.f; if (t < 2) x2 = 0.f; }
                const float cv = __builtin_fmaf(w2[j], gv[j], __builtin_fmaf(w1[j], x1, __builtin_fmaf(w0[j], x2, bb[j])));
                const float e = __builtin_amdgcn_exp2f(cv * -1.4426950408889634f);
                hv[j] = cv * __builtin_amdgcn_rcpf(1.0f + e) * (acc[ai][1][m][j >> 2][j & 3] * rr);
            }
            if (tok >= T0 + 2 && tok < M) { u32x4 w; w.x = cvt_pk_bf16(hv[0], hv[1]); w.y = cvt_pk_bf16(hv[2], hv[3]); w.z = cvt_pk_bf16(hv[4], hv[5]); w.w = cvt_pk_bf16(hv[6], hv[7]);
                *(u32x4*)(H + blk_off(tok, col, DFF)) = w; }
        }
    }
};
struct MergedOrder {
    int G, c;
    __device__ bool next(int i, Unit& u) const {
        u.ka = 0;
        if (G & 7) { const int L = i * G + c; if (L >= 65 * 86) return false; u.pm = L % 65; u.pn = L / 65; return true; }
        const int xcd = c & 7, slot = i * (G >> 3) + (c >> 3);
        if (slot < 688) { u.pm = 8 * xcd + (slot & 7); u.pn = slot >> 3; return true; }
        const int e = (slot - 688) * 8 + xcd; if (e >= 86) return false;
        u.pm = 64; u.pn = e; return true;
    }
    __device__ __forceinline__ void a_ready(const Unit&) const {}
    __device__ __forceinline__ void done(const Unit&) const {}
};
struct PoolOrder {
    int G, c;
    __device__ bool next(int i, Unit& u) const { const int L = i * G + c; if (L >= 512) return false; u.pm = L & 63; u.pn = L >> 6; u.ka = (u.pn >> 1) * 512 * 2; return true; }
    __device__ __forceinline__ void a_ready(const Unit&) const {}
    __device__ __forceinline__ void done(const Unit&) const {}
};
}

template <bool ILV = false> __device__ __forceinline__ void transpose_item(const float* W, int N, const float* gk, bf16* WT, int ldt, int row_off, int item, int lane) {
    const int nblk = N / 64, kb = item / nblk, nb = item % nblk, k0 = 64 * kb + 8 * (lane >> 3), n0 = 64 * nb + 4 * (lane & 7);
    f32x4 v[2][8];
#pragma unroll
    for (int h = 0; h < 2; ++h)
#pragma unroll
        for (int j = 0; j < 8; ++j) v[h][j] = *(const f32x4*)(W + (size_t)(k0 + j) * N + n0 + 32 * h);
    if (gk) { const f32x4 g0 = *(const f32x4*)(gk + k0), g1 = *(const f32x4*)(gk + k0 + 4);
#pragma unroll
        for (int h = 0; h < 2; ++h)
#pragma unroll
            for (int j = 0; j < 4; ++j) { v[h][j] = v[h][j] * g0[j]; v[h][4 + j] = v[h][4 + j] * g1[j]; } }
#pragma unroll
    for (int h = 0; h < 2; ++h)
#pragma unroll
        for (int i = 0; i < 4; ++i) {
            v4u o; o.x = pk2(v[h][0][i], v[h][1][i]); o.y = pk2(v[h][2][i], v[h][3][i]); o.z = pk2(v[h][4][i], v[h][5][i]); o.w = pk2(v[h][6][i], v[h][7][i]);
            const int n = n0 + 32 * h + i, nrow = ILV ? (((n >> 7) << 8) + (n & 127) + row_off) : (row_off + n);
            const int c32 = nrow & 31, srow = (nrow & ~31) + ((((c32 >> 2) & 1) << 4) | ((c32 >> 3) << 2) | (c32 & 3));
            *(v4u*)(WT + ((size_t)(srow >> 4) * (ldt >> 5) + (k0 >> 5)) * 512 + (srow & 15) * 32 + (k0 & 31)) = o; }
}

__device__ __forceinline__ attn::BlockRef<attn::bf16, attn::bf16> attn_ref(int idx, int bx, int G, const bf16* Qb, const bf16* Kb, const bf16* Vb, bf16* O0, bf16* O1) {
    using ABf = attn::bf16;
    const int i = idx >> 1, pass = idx & 1; const int L = bx + G * i, xcd = L & 7, k = L >> 3;
    const int gi = xcd * 8 + (k >> 4), r = k & 15, vh = r >> 3, y = r & 7;
    const int b = gi >> 4, h = (gi >> 1) & 7, c = gi & 1; const int qb = pass ? 15 - y : y;
    attn::BlockRef<ABf, ABf> br;
    br.Q = (const ABf*)Qb + ((size_t)b * SEQ + (size_t)qb * 256) * 2048 + (h * 2 + c) * 128;
    br.K = (const ABf*)Kb + ((size_t)b * SEQ) * 2048 + (h * 2 + c) * 128;
    br.V = (const ABf*)Vb + ((size_t)b * SEQ) * 2048 + h * 256 + vh * 128;
    br.O = (ABf*)(c ? O1 : O0) + ((size_t)b * SEQ + (size_t)qb * 256) * 2048 + h * 256 + vh * 128;
    br.P0 = qb * 256; return br;
}

#define XB_TMO      128
#define XB_XCNT(j)  (256  + 64 * (j))
#define XB_XSUB(j)  (1280 + 64 * (j))
#define XB_XGEN(j)  (2304 + 64 * (j))
#define XB_TOP      3328
#define XB_TOPGEN   3392
#define XCD_BAR_WORDS 3456
#define XB_SPIN_CAP (1u << 18)

__device__ __forceinline__ unsigned xb_ld(unsigned* p)              { return __hip_atomic_load(p, __ATOMIC_RELAXED, __HIP_MEMORY_SCOPE_AGENT); }
__device__ __forceinline__ unsigned xb_add(unsigned* p, unsigned v) { return __hip_atomic_fetch_add(p, v, __ATOMIC_RELAXED, __HIP_MEMORY_SCOPE_AGENT); }
__device__ __forceinline__ unsigned xb_xcc_id() { return (unsigned)__builtin_amdgcn_s_getreg((3 << 11) | 20) & 0xFu; }
#define XB_SPIN(cond, bar) do { unsigned _sp = 0; while (cond) { __builtin_amdgcn_s_sleep(1); \
    if ((++_sp & 255u) == 0u) { if (xb_ld(&(bar)[XB_TMO])) break; if (_sp > XB_SPIN_CAP) { atomicAdd(&(bar)[XB_TMO], 1u); break; } } } } while (0)

struct XcdBarrier {
    unsigned* bar; unsigned x;
    volatile LAS unsigned* st;
};

__device__ __forceinline__ XcdBarrier xcd_barrier_post(unsigned* bar, volatile LAS unsigned* st) {
    XcdBarrier b; b.bar = bar; b.x = xb_xcc_id(); b.st = st;
    if (threadIdx.x == 0) (void)xb_add(&bar[XB_XCNT(b.x)], 1u);
    return b;
}
__device__ __forceinline__ void xcd_barrier_complete(unsigned* bar, unsigned x, unsigned& nloc, unsigned& nx) {
    const unsigned G = gridDim.x * gridDim.y * gridDim.z;
    unsigned sum, cnt, mine, sp = 0u;
    for (;;) {
        sum = 0u; cnt = 0u; mine = 0u;
#pragma unroll
        for (unsigned j = 0; j < 16; ++j) { const unsigned c = xb_ld(&bar[XB_XCNT(j)]); sum += c; cnt += (c > 0u) ? 1u : 0u; mine = (j == x) ? c : mine; }
        if (sum == G) break;
        __builtin_amdgcn_s_sleep(1);
        if ((++sp & 255u) == 0u) { if (xb_ld(&bar[XB_TMO])) break; if (sp > XB_SPIN_CAP) { atomicAdd(&bar[XB_TMO], 1u); break; } }
    }
    nloc = mine > 0u ? mine : 1u; nx = cnt > 0u ? cnt : 1u;
}

__device__ __forceinline__ void xcd_barrier(const XcdBarrier& b) {
    asm volatile("s_waitcnt vmcnt(0)" ::: "memory");
    __syncthreads();
    if (threadIdx.x == 0) {
        unsigned* bar = b.bar;
        __builtin_amdgcn_s_waitcnt(0);
        unsigned nloc = b.st[0], nx = b.st[1];
        if (nloc == 0u) { xcd_barrier_complete(bar, b.x, nloc, nx); b.st[0] = nloc; b.st[1] = nx; }
        const unsigned old = xb_add(&bar[XB_XSUB(b.x)], 1u);
        const unsigned gen = old / nloc;
        if (old + 1u == (gen + 1u) * nloc) {
            __builtin_amdgcn_fence(__ATOMIC_RELEASE, "agent");
            asm volatile("s_waitcnt vmcnt(0)" ::: "memory");
            const unsigned og = xb_add(&bar[XB_TOP], 1u);
            const unsigned tg = og / nx;
            if (og + 1u == (tg + 1u) * nx) xb_add(&bar[XB_TOPGEN], 1u);
            else XB_SPIN(xb_ld(&bar[XB_TOPGEN]) == tg, bar);
            __builtin_amdgcn_fence(__ATOMIC_ACQUIRE, "agent");
            xb_add(&bar[XB_XGEN(b.x)], 1u);
            asm volatile("s_waitcnt vmcnt(0)" ::: "memory");
        } else {
            XB_SPIN(xb_ld(&bar[XB_XGEN(b.x)]) == gen, bar);
            __builtin_amdgcn_fence(__ATOMIC_ACQUIRE, "agent");
            asm volatile("s_waitcnt vmcnt(0)" ::: "memory");
        }
    }
    __syncthreads();
}

struct Args { const float* in[19]; float* out; unsigned char* ws; };

__global__ void __launch_bounds__(NTHREADS, 2) mk_fwd(Args a) {
    extern __shared__ __attribute__((aligned(16))) unsigned char lds[];
    cg::grid_group grid = cg::this_grid();
    LAS unsigned char* ldsl = (LAS unsigned char*)lds;
    const int G = gridDim.x, bx = blockIdx.x;
    const int vcu = (G % 8 == 0) ? (bx % 8) * (G / 8) + bx / 8 : bx;
    const int NGW = G * NWAVES, NGT = NGW * 64;
#define THREAD_IDS() const int tid = pg8::mk_tid(), lane = tid & 63, wave = __builtin_amdgcn_readfirstlane(tid >> 6), gw = vcu * NWAVES + wave, gt = gw * 64 + lane; (void)gt; LAS float* scr = (LAS float*)(ldsl + wave * 16384); (void)scr
    unsigned char* ws = a.ws;
    volatile LAS unsigned* bar_st = (volatile LAS unsigned*)(ldsl + 131072 + 512);
    if (threadIdx.x < 2) bar_st[threadIdx.x] = 0u;
    __syncthreads();
    const XcdBarrier bar = xcd_barrier_post((unsigned*)(ws + WS_BAR), bar_st);
    const float* x = a.in[0]; const int* positions = (const int*)a.in[1]; const float* norm1_g = a.in[2]; const float* w_in = a.in[3];
    const float* lq1 = a.in[4]; const float* lk1 = a.in[5]; const float* lq2 = a.in[6]; const float* lk2 = a.in[7];
    const float* subln_g = a.in[8]; const float* w_pool = a.in[9]; const float* pool_scale = a.in[10]; const float* w_out = a.in[11];
    const float* norm2_g = a.in[12]; const float* w_gate = a.in[13]; const float* w_up = a.in[14]; const float* conv_w = a.in[15];
    const float* conv_b = a.in[16]; const float* w_down = a.in[17]; const float* norm_f_g = a.in[18];
    float* out = a.out;
    float* SS1 = (float*)(ws + WS_SS1); float* SS2 = (float*)(ws + WS_SS2); float* COS = (float*)(ws + WS_COS); float* SIN = (float*)(ws + WS_SIN);
    bf16* Wgate_t = (bf16*)(ws + WS_WGATE); bf16* Wup_t = (bf16*)(ws + WS_WUP); bf16* Wdown_t = (bf16*)out;
    bf16* HB = (bf16*)(ws + WS_HB); bf16* GATE = (bf16*)(ws + WS_GATE); bf16* HID = (bf16*)(ws + WS_HID);
    bf16* Win_t = (bf16*)(ws + WS_WIN); bf16* Wout_t = (bf16*)(ws + WS_WOUT); bf16* Wpool_t = (bf16*)(ws + WS_WPOOL);
    bf16* N1 = (bf16*)(ws + WS_N1); bf16* MIX = (bf16*)(ws + WS_N1);
    bf16* Qb = (bf16*)(ws + WS_Q); bf16* Kb = (bf16*)(ws + WS_K); bf16* Vb = (bf16*)(ws + WS_V); bf16* Ub = (bf16*)(ws + WS_U);
    bf16* POOLED = (bf16*)(ws + WS_POOLED); bf16* O0 = (bf16*)(ws + WS_O0); bf16* O1 = (bf16*)(ws + WS_O1);

    {
        THREAD_IDS();
        constexpr int I_IN = (DM / 64) * (INW / 64), I_OUT = (DM / 64) * (DM / 64), I_G = (DM / 64) * (DFF / 64), I_P = 4 * (512 / 64) * (512 / 64);
        constexpr int I_D = (DFF / 64) * (DM / 64);
        constexpr int NITEMS = I_IN + I_OUT + 2 * I_G + I_D + I_P;
        for (int it = gw; it < NITEMS; it += NGW) {
            int r = it;
            if (r < I_IN) { transpose_item(w_in, INW, nullptr, Win_t, DM, 0, r, lane); continue; } r -= I_IN;
            if (r < I_OUT) { transpose_item(w_out, DM, nullptr, Wout_t, DM, 0, r, lane); continue; } r -= I_OUT;
            if (r < I_G) { transpose_item<true>(w_gate, DFF, norm2_g, Wgate_t, DM, 0, r, lane); continue; } r -= I_G;
            if (r < I_G) { transpose_item<true>(w_up, DFF, norm2_g, Wgate_t, DM, 128, r, lane); continue; } r -= I_G;
            if (r < I_D) { transpose_item(w_down, DM, nullptr, Wdown_t, DFF, 0, r, lane); continue; } r -= I_D;
            { const int g = r / (I_P / 4), rr = r % (I_P / 4); transpose_item(w_pool + (size_t)g * 512 * 512, 512, nullptr, Wpool_t, 512, g * 512, rr, lane); }
        }
        for (int m = gw; m < M; m += NGW) {
            const f32x4* xr = (const f32x4*)(x + (size_t)m * DM) + lane;
            f32x4 v[16]; float s = 0.f;
#pragma unroll
            for (int j = 0; j < 16; ++j) { v[j] = xr[64 * j]; s += (v[j].x * v[j].x + v[j].y * v[j].y) + (v[j].z * v[j].z + v[j].w * v[j].w); }
            const float rinv = 1.0f / sqrtf(wave_sum(s) * (1.0f / DM) + NORM_EPS);
            v2u* o8 = (v2u*)(N1 + (size_t)m * DM) + lane;
#pragma unroll
            for (int j = 0; j < 16; ++j) { const f32x4 g = ((const f32x4*)norm1_g)[lane + 64 * j]; v2u w; w.x = pk2(v[j].x * rinv * g.x, v[j].y * rinv * g.y); w.y = pk2(v[j].z * rinv * g.z, v[j].w * rinv * g.w); o8[64 * j] = w; }
        }
        for (int idx = gt; idx < M * 16; idx += NGT) {
            const int m = idx >> 4, i = idx & 15;
            const float inv = exp2f(-(float)i * (18.931568569324174f / 16.0f));
            const float ang = (float)positions[m] * inv;
            COS[idx] = cosf(ang); SIN[idx] = sinf(ang);
        }
        for (int idx = gt; idx < M; idx += NGT) { SS1[idx] = 0.f; SS2[idx] = 0.f; }
    }
    if (a.ws == nullptr) grid.sync();
    xcd_barrier(bar);

    {
        pg8::Gemm g{N1, Win_t, M, INW, DM, DM, DM}; pg8::StaticOrder S; S.init(M, INW, G, bx);
        pg8::EpiQKVU E{Qb, COS, SIN};
        pg8::gemm_phase<pg8::EpiQKVU, pg8::StaticOrder, true, true>(ldsl, g, S, E);
    }
    xcd_barrier(bar);

    {
        THREAD_IDS();
        for (int task = gt; task < (M / 32) * 256; task += NGT) {
            const int ct = task & 255, rc = task >> 8, c0 = ct * 8, m0 = rc * 32, t0 = m0 & (SEQ - 1);
            const int w = 2 << (ct >> 6);
            float sum[8];
#pragma unroll
            for (int j = 0; j < 8; ++j) sum[j] = 0.f;
            for (int i = 1; i < w; ++i) {
                if (t0 - i >= 0) { const v4u q = *(const v4u*)(Ub + (size_t)(m0 - i) * 2048 + c0);
#pragma unroll
                    for (int j = 0; j < 4; ++j) { sum[2 * j] += bflo(q[j]); sum[2 * j + 1] += bfhi(q[j]); } }
            }
            for (int r = 0; r < 32; ++r) {
                const int t = t0 + r; const v4u q = *(const v4u*)(Ub + (size_t)(m0 + r) * 2048 + c0);
                float cur[8];
#pragma unroll
                for (int j = 0; j < 4; ++j) { cur[2 * j] = bflo(q[j]); cur[2 * j + 1] = bfhi(q[j]); }
#pragma unroll
                for (int j = 0; j < 8; ++j) sum[j] += cur[j];
                const float ic = 1.0f / (float)((t + 1 < w) ? (t + 1) : w);
                v4u pw;
#pragma unroll
                for (int j = 0; j < 4; ++j) pw[j] = pk2(sum[2 * j] * ic - cur[2 * j], sum[2 * j + 1] * ic - cur[2 * j + 1]);
                *(v4u*)(POOLED + (size_t)(m0 + r) * 2048 + c0) = pw;
                if (t - w + 1 >= 0) { const v4u o = *(const v4u*)(Ub + (size_t)(m0 + r - w + 1) * 2048 + c0);
#pragma unroll
                    for (int j = 0; j < 4; ++j) { sum[2 * j] -= bflo(o[j]); sum[2 * j + 1] -= bfhi(o[j]); } }
            }
        }
        __syncthreads();
        if (bx < 1024) {
            using ABf = attn::bf16; typedef attn::BlockRef<ABf, ABf> BR;
            const int nblk = 2 * ((1024 - bx + G - 1) / G);
            attn::Seam<ABf> S;
            BR cur = attn_ref(0, bx, G, Qb, Kb, Vb, O0, O1);
            attn::causal_swa_prime<ABf, ABf>(cur, SEQ, (char*)lds, S);
            for (int idx = 0; idx < nblk; ++idx) {
                const BR nxt = (idx == nblk - 1) ? cur : attn_ref(idx + 1, bx, G, Qb, Kb, Vb, O0, O1);
                attn::causal_swa_block<ABf, ABf>(cur, nxt, SEQ, SEQ, (char*)lds, S);
                cur = nxt;
            }
        }
    }
    xcd_barrier(bar);

    {
        {
            pg8::Gemm g{POOLED, Wpool_t, M, PW, 512, 2048, 512}; pg8::PoolOrder S{G, bx};
            pg8::EpiScaleBf16<true, false> E{MIX, DM, AW, pool_scale, nullptr};
            pg8::gemm_phase<pg8::EpiScaleBf16<true, false>, pg8::PoolOrder, true, true>(ldsl, g, S, E);
        }
        THREAD_IDS();
        float lam;
        { const float s1 = wave_sum(lq1[lane] * lk1[lane] + lq1[lane + 64] * lk1[lane + 64]), s2 = wave_sum(lq2[lane] * lk2[lane] + lq2[lane + 64] * lk2[lane + 64]);
          lam = expf(s1) - expf(s2) + 0.2f; }
        const int l32 = lane & 31, e0 = l32 * 8;
        float sg[8];
#pragma unroll
        for (int j = 0; j < 8; ++j) sg[j] = subln_g[e0 + j] * 0.8f;
        for (int p = gw * 2 + (lane >> 5); p < M * NHEAD; p += NGW * 2) {
            const int m = p >> 3, h = p & 7; const size_t off = (size_t)m * 2048 + h * 256 + e0;
            const v4u a0 = *(const v4u*)(O0 + off), a1 = *(const v4u*)(O1 + off);
            float d[8]; float ssq = 0.f;
#pragma unroll
            for (int j = 0; j < 4; ++j) { d[2 * j] = bflo(a0[j]) - lam * bflo(a1[j]); d[2 * j + 1] = bfhi(a0[j]) - lam * bfhi(a1[j]); ssq += d[2 * j] * d[2 * j] + d[2 * j + 1] * d[2 * j + 1]; }
#pragma unroll
            for (int o = 1; o < 32; o <<= 1) ssq += __shfl_xor(ssq, o);
            const float rinv = 1.0f / sqrtf(ssq * (1.0f / 256.0f) + SUBLN_EPS);
            v4u w;
#pragma unroll
            for (int j = 0; j < 4; ++j) w[j] = pk2(d[2 * j] * rinv * sg[2 * j], d[2 * j + 1] * rinv * sg[2 * j + 1]);
            *(v4u*)(MIX + (size_t)m * DM + h * 256 + e0) = w;
        }
    }
    xcd_barrier(bar);

    {
        pg8::Gemm g{MIX, Wout_t, M, DM, DM, DM, DM}; pg8::StaticOrder S; S.init(M, DM, G, bx);
        pg8::EpiResidBf<true> E{x, HB, SS1};
        pg8::gemm_phase<pg8::EpiResidBf<true>, pg8::StaticOrder, true, true>(ldsl, g, S, E);
    }
    xcd_barrier(bar);

    {
        pg8::Gemm g{HB, Wgate_t, 65 * 256, 2 * DFF, DM, DM, DM}; pg8::MergedOrder S{G, bx};
        pg8::EpiGateUp E{HID, conv_w, conv_b, SS1, (LAS float*)(ldsl + 131072 + 1024)};
        pg8::gemm_phase<pg8::EpiGateUp, pg8::MergedOrder, true, true>(ldsl, g, S, E);
    }
    xcd_barrier(bar);

    {
        pg8::Gemm g{HID, Wdown_t, M, DM, DFF, DFF, DFF}; pg8::StaticOrder S; S.init(M, DM, G, bx);
        pg8::EpiResidBf<false> E{nullptr, HB, SS2};
        pg8::gemm_phase<pg8::EpiResidBf<false>, pg8::StaticOrder, true, true>(ldsl, g, S, E);
    }
    xcd_barrier(bar);

    { THREAD_IDS();
    for (int m = gw; m < M; m += NGW) {
        const int hrw = hb_row(m); f32x4* orow = (f32x4*)(out + (size_t)m * DM) + 2 * lane;
        const float rinv = 1.0f / sqrtf(SS2[m] * (1.0f / DM) + NORM_EPS);
        v4u q[8];
#pragma unroll
        for (int j = 0; j < 8; ++j) q[j] = *(const v4u*)(HB + blk_off(hrw, 8 * (lane + 64 * j), DM));
#pragma unroll
        for (int j = 0; j < 8; ++j) { const f32x4 g0 = ((const f32x4*)norm_f_g)[2 * lane + 128 * j], g1 = ((const f32x4*)norm_f_g)[2 * lane + 128 * j + 1];
            orow[128 * j] = (f32x4){bflo(q[j].x), bfhi(q[j].x), bflo(q[j].y), bfhi(q[j].y)} * rinv * g0;
            orow[128 * j + 1] = (f32x4){bflo(q[j].z), bfhi(q[j].z), bflo(q[j].w), bfhi(q[j].w)} * rinv * g1; }
    } }
}

extern "C" void kernel_launch(void* const* d_in, const int* in_sizes, int n_in, void* d_out, int out_size, void* d_ws, size_t ws_size, hipStream_t stream) {
    static int grid = 0;
    if (grid == 0) {
        if (n_in != 19 || out_size != M * DM || ws_size < WS_END) { fprintf(stderr, "kernel_launch: unexpected shapes n_in %d out %d ws %zu\n", n_in, out_size, ws_size); grid = -1; return; }
        int dev = 0, cus = 0, per_cu = 0;
        (void)hipGetDevice(&dev);
        (void)hipDeviceGetAttribute(&cus, hipDeviceAttributeMultiprocessorCount, dev);
        if (hipFuncSetAttribute((const void*)mk_fwd, hipFuncAttributeMaxDynamicSharedMemorySize, LDS_BYTES) != hipSuccess) { fprintf(stderr, "kernel_launch: hipFuncSetAttribute failed\n"); grid = -1; return; }
        if (hipOccupancyMaxActiveBlocksPerMultiprocessor(&per_cu, (const void*)mk_fwd, NTHREADS, LDS_BYTES) != hipSuccess || per_cu < 1) { fprintf(stderr, "kernel_launch: occupancy query says %d\n", per_cu); per_cu = 1; }
        (void)hipGetLastError();
        grid = cus * per_cu;
        fprintf(stderr, "kernel_launch: grid %d (cus %d x %d)\n", grid, cus, per_cu);
    }
    if (grid < 0) return;
    if (hipMemsetAsync((char*)d_ws + WS_BAR, 0, WS_BAR_BYTES, stream) != hipSuccess) { fprintf(stderr, "kernel_launch: memset of the barrier words failed\n"); return; }
    Args a{};
    for (int i = 0; i < 19; ++i) a.in[i] = (const float*)d_in[i];
    a.out = (float*)d_out; a.ws = (unsigned char*)d_ws;
    void* args[] = {&a};
    hipError_t e = hipLaunchCooperativeKernel((const void*)mk_fwd, dim3(grid), dim3(NTHREADS), args, LDS_BYTES, stream);
    if (e != hipSuccess) fprintf(stderr, "kernel_launch: cooperative launch failed: %s (grid %d)\n", hipGetErrorString(e), grid);
}
```
